# Optimizing an MI355X kernel written in HIP

```python
import math
import jax, jax.numpy as jnp
from jax import lax
import numpy as np

D_MODEL = 1024
BATCH = 8
SEQ = 2048
DEPTH = 1

MEM_LEN = 256
HEAD_DIM = 64
ATTN_WIDTH = D_MODEL // 2
N_Q_HEADS = ATTN_WIDTH // HEAD_DIM
N_KV_HEADS = N_Q_HEADS // 4
Q_PER_KV = N_Q_HEADS // N_KV_HEADS
WINDOW = 128
BLOCK = 128
CONV_CH = D_MODEL // 4
CONV_WIDTH = 31
MEM_WIDTH = D_MODEL // 4
N_MEM_HEADS = MEM_WIDTH // HEAD_DIM
MIX_WIDTH = ATTN_WIDTH + CONV_CH + MEM_WIDTH
ROPE_THETA = 500000.0
ROPE_DIM = HEAD_DIM // 4
D_FF = 256 * math.ceil(8 * D_MODEL / 3 / 256)
EPS = 1e-6

Q_COLS = N_Q_HEADS * HEAD_DIM
KV_COLS = N_KV_HEADS * HEAD_DIM
GLU_COLS = 2 * CONV_CH
MQ_COLS = N_MEM_HEADS * HEAD_DIM
IN_COLS = Q_COLS + 2 * KV_COLS + GLU_COLS + MQ_COLS
SPLITS = [Q_COLS, Q_COLS + KV_COLS, Q_COLS + 2 * KV_COLS, Q_COLS + 2 * KV_COLS + GLU_COLS]

kernel_name = "hymba_conformer_swa_sink_memory_layer"


def rms_norm(x, g):
    xf = x.astype(jnp.float32)
    y = xf * lax.rsqrt(jnp.mean(xf * xf, axis=-1, keepdims=True) + EPS)
    return (y * g.astype(jnp.float32)).astype(x.dtype)


def layer_norm(x, g, b):
    xf = x.astype(jnp.float32)
    mu = jnp.mean(xf, axis=-1, keepdims=True)
    var = jnp.mean(jnp.square(xf - mu), axis=-1, keepdims=True)
    y = (xf - mu) * lax.rsqrt(var + EPS)
    return (y * g.astype(jnp.float32) + b.astype(jnp.float32)).astype(x.dtype)


def swiglu(x, w_gate, w_up, w_down):
    return (jax.nn.silu(x @ w_gate) * (x @ w_up)) @ w_down


def rope_partial(x, positions):
    half = ROPE_DIM // 2
    inv_freq = ROPE_THETA ** (-jnp.arange(half, dtype=jnp.float32) / half)
    ang = positions.astype(jnp.float32)[..., None] * inv_freq
    cos = jnp.cos(ang)[:, :, None, :]
    sin = jnp.sin(ang)[:, :, None, :]
    xr = x[..., :ROPE_DIM].astype(jnp.float32)
    x1, x2 = xr[..., :half], xr[..., half:]
    rot = jnp.concatenate([x1 * cos - x2 * sin, x2 * cos + x1 * sin], axis=-1).astype(x.dtype)
    return jnp.concatenate([rot, x[..., ROPE_DIM:]], axis=-1)


def sliding_window_attention(q, k, v, sinks):
    B, T = q.shape[0], q.shape[1]
    nb = T // BLOCK
    qb = q.reshape(B, nb, BLOCK, N_KV_HEADS, Q_PER_KV, HEAD_DIM)

    def with_prev(a):
        a = a.reshape(B, nb, BLOCK, N_KV_HEADS, HEAD_DIM)
        prev = jnp.pad(a, ((0, 0), (1, 0), (0, 0), (0, 0), (0, 0)))[:, :-1]
        return jnp.concatenate([prev, a], axis=2)

    kb, vb = with_prev(k), with_prev(v)
    s = jnp.einsum('bnqgrd,bnkgd->bngrqk', qb, kb).astype(jnp.float32) * (HEAD_DIM ** -0.5)
    qi = jnp.arange(BLOCK)[:, None] + BLOCK
    ki = jnp.arange(2 * BLOCK)[None, :]
    rel = qi - ki
    band = (rel >= 0) & (rel < WINDOW)
    blk = jnp.arange(nb)[:, None, None]
    valid = band[None] & ((blk > 0) | (ki >= BLOCK)[None])
    s = jnp.where(valid[None, :, None, None], s, -jnp.inf)
    sink = sinks.astype(jnp.float32).reshape(N_KV_HEADS, Q_PER_KV)[None, None, :, :, None, None]
    m = jnp.maximum(jnp.max(s, axis=-1, keepdims=True), sink)
    p = jnp.exp(s - m)
    denom = jnp.sum(p, axis=-1, keepdims=True) + jnp.exp(sink - m)
    w = (p / denom).astype(v.dtype)
    o = jnp.einsum('bngrqk,bnkgd->bnqgrd', w, vb)
    return o.reshape(B, T, N_Q_HEADS * HEAD_DIM)


def memory_cross_attention(q, k, v):
    B, T = q.shape[0], q.shape[1]
    s = jnp.einsum('bthd,bmhd->bhtm', q, k).astype(jnp.float32) * (HEAD_DIM ** -0.5)
    w = jax.nn.softmax(s, axis=-1).astype(v.dtype)
    o = jnp.einsum('bhtm,bmhd->bthd', w, v)
    return o.reshape(B, T, N_MEM_HEADS * HEAD_DIM)


def conformer_conv(u, w_dw, b_dw, g_ln, b_ln):
    a, gate = jnp.split(u, 2, axis=-1)
    h = a * jax.nn.sigmoid(gate)
    h = lax.conv_general_dilated(
        h, w_dw[:, None, :].astype(h.dtype), window_strides=(1,),
        padding=((CONV_WIDTH - 1, 0),), dimension_numbers=('NWC', 'WIO', 'NWC'),
        feature_group_count=CONV_CH) + b_dw
    return jax.nn.silu(layer_norm(h, g_ln, b_ln))


def setup_inputs(seed: int = 0) -> dict:
    key = jax.random.key(seed)
    ks = jax.random.split(key, 32)
    f32 = jnp.float32

    def w(k, shape, fan_in):
        return jax.random.normal(k, shape, f32) * (fan_in ** -0.5)

    def gain(k, shape):
        return 1.0 + 0.05 * jax.random.normal(k, shape, f32)

    L = DEPTH
    start = jax.random.randint(ks[2], (BATCH, 1), 0, 1024, dtype=jnp.int32)
    positions = start + jnp.arange(SEQ, dtype=jnp.int32)[None, :]
    return {
        "x": jax.random.normal(ks[0], (BATCH, SEQ, D_MODEL), f32),
        "mem": jax.random.normal(ks[1], (BATCH, MEM_LEN, D_MODEL), f32),
        "positions": positions,
        "g_ffn1": gain(ks[3], (L, D_MODEL)),
        "w_ffn1_gate": w(ks[4], (L, D_MODEL, D_FF), D_MODEL),
        "w_ffn1_up": w(ks[5], (L, D_MODEL, D_FF), D_MODEL),
        "w_ffn1_down": w(ks[6], (L, D_FF, D_MODEL), D_FF),
        "g_mix": gain(ks[7], (L, D_MODEL)),
        "w_in": w(ks[8], (L, D_MODEL, IN_COLS), D_MODEL),
        "g_q": gain(ks[9], (L, HEAD_DIM)),
        "g_k": gain(ks[10], (L, HEAD_DIM)),
        "sinks": 0.5 * jax.random.normal(ks[11], (L, N_Q_HEADS), f32),
        "w_dw": w(ks[12], (L, CONV_WIDTH, CONV_CH), CONV_WIDTH),
        "b_dw": 0.02 * jax.random.normal(ks[13], (L, CONV_CH), f32),
        "g_conv_ln": gain(ks[14], (L, CONV_CH)),
        "b_conv_ln": 0.02 * jax.random.normal(ks[15], (L, CONV_CH), f32),
        "g_mem": gain(ks[16], (L, D_MODEL)),
        "w_mem_kv": w(ks[17], (L, D_MODEL, 2 * MQ_COLS), D_MODEL),
        "g_mq": gain(ks[18], (L, HEAD_DIM)),
        "g_mk": gain(ks[19], (L, HEAD_DIM)),
        "w_out": w(ks[20], (L, MIX_WIDTH, D_MODEL), MIX_WIDTH),
        "g_ffn2": gain(ks[21], (L, D_MODEL)),
        "w_ffn2_gate": w(ks[22], (L, D_MODEL, D_FF), D_MODEL),
        "w_ffn2_up": w(ks[23], (L, D_MODEL, D_FF), D_MODEL),
        "w_ffn2_down": w(ks[24], (L, D_FF, D_MODEL), D_FF),
    }


def reference(x, mem, positions, g_ffn1, w_ffn1_gate, w_ffn1_up, w_ffn1_down,
              g_mix, w_in, g_q, g_k, sinks, w_dw, b_dw, g_conv_ln, b_conv_ln,
              g_mem, w_mem_kv, g_mq, g_mk, w_out,
              g_ffn2, w_ffn2_gate, w_ffn2_up, w_ffn2_down):
    B, T = x.shape[0], x.shape[1]
    M = mem.shape[1]
    for l in range(DEPTH):
        x = x + 0.5 * swiglu(rms_norm(x, g_ffn1[l]), w_ffn1_gate[l], w_ffn1_up[l], w_ffn1_down[l])

        h = rms_norm(x, g_mix[l])
        proj = h @ w_in[l]
        q, k, v, u, mq = jnp.split(proj, SPLITS, axis=-1)
        q = q.reshape(B, T, N_Q_HEADS, HEAD_DIM)
        k = k.reshape(B, T, N_KV_HEADS, HEAD_DIM)
        v = v.reshape(B, T, N_KV_HEADS, HEAD_DIM)
        q = rope_partial(rms_norm(q, g_q[l]), positions)
        k = rope_partial(rms_norm(k, g_k[l]), positions)
        y_attn = sliding_window_attention(q, k, v, sinks[l])

        y_conv = conformer_conv(u, w_dw[l], b_dw[l], g_conv_ln[l], b_conv_ln[l])

        mkv = rms_norm(mem, g_mem[l]) @ w_mem_kv[l]
        mk, mv = jnp.split(mkv, 2, axis=-1)
        mq = rms_norm(mq.reshape(B, T, N_MEM_HEADS, HEAD_DIM), g_mq[l])
        mk = rms_norm(mk.reshape(B, M, N_MEM_HEADS, HEAD_DIM), g_mk[l])
        mv = mv.reshape(B, M, N_MEM_HEADS, HEAD_DIM)
        y_mem = memory_cross_attention(mq, mk, mv)

        x = x + jnp.concatenate([y_attn, y_conv, y_mem], axis=-1) @ w_out[l]

        x = x + 0.5 * swiglu(rms_norm(x, g_ffn2[l]), w_ffn2_gate[l], w_ffn2_up[l], w_ffn2_down[l])
    return x
```

```cpp
#include <hip/hip_runtime.h>
#include <hip/hip_cooperative_groups.h>
#include <cstdio>
#include <cstdint>
namespace cg = cooperative_groups;
namespace pg8 {
#define PG8_LAS __attribute__((address_space(3)))
typedef unsigned short bf16_t;
typedef short bf16x8 __attribute__((ext_vector_type(8)));
typedef float f32x4 __attribute__((ext_vector_type(4)));
typedef unsigned u32x4 __attribute__((ext_vector_type(4)));
constexpr int BM = 256, BK = 64, HALF = 128, HTB = HALF * BK * 2  , STAGE_BYTES = 8 * HTB, NXCD = 8, WGM = 8;

__host__ __device__ __forceinline__ int lds_byte(int r, int c) { const int st = (r >> 4) * 2 + (c >> 5), rr = r & 15, cc = c & 31, ob = rr * 64 + cc * 2; return st * 1024 + (ob ^ (((ob >> 9) & 1) << 5)); }
__host__ __device__ __forceinline__ void stage_rc(int b, int& R, int& C) { const int st = b / 1024, sb = b % 1024, swz = sb ^ (((sb >> 9) & 1) << 5); R = (st >> 1) * 16 + swz / 64; C = (st & 1) * 32 + (swz % 64) / 2; }
__host__ __device__ __forceinline__ int perm32(int rho) { const int n = rho >> 4, i = rho & 15; return 8 * (i >> 2) + 4 * n + (i & 3); }

struct Unit { int pm, pn; };
struct Gemm { const bf16_t* A; const bf16_t* Bt; int M, N, K; int apitch, akstep, bpitch, bkstep; };

struct StaticOrder {
    int nM, nN, nwg, G, c;
    __host__ __device__ void init(int M, int N, int G_, int c_) { nM = M / BM; nN = N / BM; nwg = nM * nN; G = G_; c = c_; }
    __host__ __device__ bool next(int i, Unit& u) const {
        const long L = (long)i * G + c; if (L >= nwg) return false;
        int wgid = (int)L; { const int q = nwg / NXCD, r = nwg % NXCD, xcd = wgid % NXCD, off = wgid / NXCD; wgid = (xcd < r ? xcd * (q + 1) : r * (q + 1) + (xcd - r) * q) + off; }
        const int nig = WGM * nN, gid = wgid / nig, fm = gid * WGM, gsz = (nM - fm) < WGM ? (nM - fm) : WGM;
        u.pm = fm + ((wgid % nig) % gsz); u.pn = (wgid % nig) / gsz; return true;
    }
    __device__ __forceinline__ void a_ready(const Unit&) const {}
    __device__ __forceinline__ void done(const Unit&) const {}
};

__device__ __forceinline__ unsigned cvt_pk_bf16(float lo, float hi) { unsigned r; asm volatile("v_cvt_pk_bf16_f32 %0, %1, %2" : "=v"(r) : "v"(lo), "v"(hi)); return r; }
__device__ __forceinline__ void st16_wt(const void* base, unsigned off, u32x4 v) {
    __amdgpu_buffer_rsrc_t r = __builtin_amdgcn_make_buffer_rsrc(const_cast<void*>(base), 0, 0x7fffffff, 0x00020000);
    __builtin_amdgcn_raw_buffer_store_b128(v, r, (int)off, 0, 16);
}
__device__ __forceinline__ void st16_wt(const void* base, unsigned off, f32x4 v) { st16_wt(base, off, __builtin_bit_cast(u32x4, v)); }
typedef float f32x2 __attribute__((ext_vector_type(2)));
template <class Epi, class Sched, bool ALIGN_EPI = false, bool SP2 = false>
__device__ __forceinline__ void gemm_phase(PG8_LAS unsigned char* lds, const Gemm g, const Sched& S, const Epi& E) {
    const int tid = threadIdx.x, wid = __builtin_amdgcn_readfirstlane(tid >> 6), lane = tid & 63, wr = wid >> 2, wc = wid & 3, fr = lane & 15, fq = lane >> 4;
    const int K = g.K, nt = K / BK;
    unsigned voffA[2], voffB[2];
#pragma unroll
    for (int i = 0; i < 2; ++i) { int R, C; stage_rc(tid * 16 + i * 8192, R, C); const int Rb = Epi::PERM ? ((R & ~31) + perm32(R & 31)) : R;
        voffA[i] = (unsigned)(R * g.apitch + C * 2); voffB[i] = (unsigned)(Rb * g.bpitch + C * 2); }
    const size_t kstepA = (size_t)g.akstep, kstepB = (size_t)g.bkstep;
    const size_t hstepA = (size_t)HALF * g.apitch, hstepB = (size_t)HALF * g.bpitch;
    const size_t tstep = (size_t)BM * K * 2;
    const unsigned ldsw = (unsigned)wid * 1024u;
    const int aoff = lds_byte(wr * 64 + fr, fq * 8), boff = lds_byte(wc * 32 + fr, fq * 8);
#define PG8_SA(b, h) (((b) * 2 + (h)) * HTB)
#define PG8_SB(b, h) ((4 + (b) * 2 + (h)) * HTB)
#define PG8_STAGE(bufoff, gbase, voff) do { _Pragma("unroll") for (int _i = 0; _i < 2; ++_i) \
        __builtin_amdgcn_global_load_lds((const unsigned*)((const char*)(gbase) + (voff)[_i]), (PG8_LAS unsigned*)(lds + (bufoff) + ldsw + _i * 8192), 16, 0, 0); } while (0)
#define PG8_LDA(dst, b, h) do { _Pragma("unroll") for (int m = 0; m < 4; ++m) _Pragma("unroll") for (int k = 0; k < 2; ++k) dst[m][k] = *(const PG8_LAS bf16x8*)(lds + PG8_SA(b, h) + aoff + m * 2048 + k * 1024); } while (0)
#define PG8_LDB(dst, b, h) do { _Pragma("unroll") for (int n = 0; n < 2; ++n) _Pragma("unroll") for (int k = 0; k < 2; ++k) dst[n][k] = *(const PG8_LAS bf16x8*)(lds + PG8_SB(b, h) + boff + n * 2048 + k * 1024); } while (0)
#define PG8_MMA(ai, bj, At, Bt) do { __builtin_amdgcn_s_setprio(1); _Pragma("unroll") for (int m = 0; m < 4; ++m) _Pragma("unroll") for (int n = 0; n < 2; ++n) _Pragma("unroll") for (int k = 0; k < 2; ++k) \
        acc[ai][bj][m][n] = __builtin_amdgcn_mfma_f32_16x16x32_bf16(Bt[n][k], At[m][k], acc[ai][bj][m][n], 0, 0, 0); __builtin_amdgcn_s_setprio(0); } while (0)
#define PG8_WAIT_V(n) asm volatile("s_waitcnt vmcnt(" #n ")" ::: "memory")
#define PG8_WAIT_L(n) asm volatile("s_waitcnt lgkmcnt(" #n ")" ::: "memory")
#define PG8_BAR __builtin_amdgcn_s_barrier()
#define PG8_SCHED __builtin_amdgcn_sched_barrier(0)
    Unit cur, nxt; int ui = 0;
    if (!S.next(0, cur)) return;
    float epre[8]; E.prefetch(epre, cur, wr, fr);
    f32x4 acc[2][2][4][2];
#pragma unroll
    for (int a = 0; a < 2; ++a)
#pragma unroll
        for (int b = 0; b < 2; ++b)
#pragma unroll
            for (int m = 0; m < 4; ++m)
#pragma unroll
                for (int n = 0; n < 2; ++n) acc[a][b][m][n] = (f32x4){0.f, 0.f, 0.f, 0.f};
    bf16x8 At[4][2], B0[2][2], B1[2][2];
    const char* cA = (const char*)g.A + (size_t)cur.pm * tstep; const char* cB = (const char*)g.Bt + (size_t)cur.pn * tstep;
    S.a_ready(cur);
    if constexpr (SP2) {
        PG8_STAGE(PG8_SB(0, 0), cB, voffB); PG8_STAGE(PG8_SB(0, 1), cB + hstepB, voffB); PG8_STAGE(PG8_SA(0, 0), cA, voffA); PG8_STAGE(PG8_SA(0, 1), cA + hstepA, voffA);
        if (wr == 1) PG8_BAR;
        PG8_WAIT_V(2); PG8_BAR;
        PG8_STAGE(PG8_SB(1, 0), cB + kstepB, voffB); PG8_STAGE(PG8_SA(1, 0), cA + kstepA, voffA); PG8_STAGE(PG8_SB(1, 1), cB + hstepB + kstepB, voffB);
        PG8_WAIT_V(6); PG8_BAR;
    } else {
        PG8_STAGE(PG8_SB(0, 0), cB, voffB); PG8_STAGE(PG8_SA(0, 0), cA, voffA); PG8_STAGE(PG8_SB(0, 1), cB + hstepB, voffB); PG8_STAGE(PG8_SA(0, 1), cA + hstepA, voffA);
        if (wr == 1) PG8_BAR;
        PG8_WAIT_V(4); PG8_BAR;
        PG8_STAGE(PG8_SB(1, 0), cB + kstepB, voffB); PG8_STAGE(PG8_SA(1, 0), cA + kstepA, voffA); PG8_STAGE(PG8_SB(1, 1), cB + hstepB + kstepB, voffB);
        PG8_WAIT_V(6); PG8_BAR;
    }
    for (;;) {
        const bool has_next = S.next(ui + 1, nxt);
        const char* nA = has_next ? (const char*)g.A + (size_t)nxt.pm * tstep : cA; const char* nB = has_next ? (const char*)g.Bt + (size_t)nxt.pn * tstep : cB;
        for (int t = 0; t < nt; t += 2) {
            const bool last = (t == nt - 2);
            const char* a1 = cA + (size_t)(t + 1) * kstepA;
            const char* a2 = last ? nA : cA + (size_t)(t + 2) * kstepA; const char* b2 = last ? nB : cB + (size_t)(t + 2) * kstepB;
            const char* a3 = a2 + kstepA; const char* b3 = b2 + kstepB;
            if (last && has_next) S.a_ready(nxt);
            if constexpr (SP2) {
            PG8_LDB(B0, 0, 0); PG8_LDB(B1, 0, 1); PG8_SCHED; PG8_LDA(At, 0, 0); PG8_STAGE(PG8_SA(1, 1), a1 + hstepA, voffA);
            PG8_WAIT_V(8); PG8_WAIT_L(0); PG8_BAR; PG8_MMA(0, 0, At, B0); PG8_MMA(0, 1, At, B1); PG8_BAR; PG8_SCHED;
            PG8_LDA(At, 0, 1); PG8_STAGE(PG8_SB(0, 0), b2, voffB); PG8_STAGE(PG8_SB(0, 1), b2 + hstepB, voffB); PG8_STAGE(PG8_SA(0, 0), a2, voffA);
            PG8_WAIT_V(8); PG8_WAIT_L(0); PG8_BAR; PG8_MMA(1, 0, At, B0); PG8_MMA(1, 1, At, B1); PG8_BAR; PG8_SCHED;
            PG8_LDB(B0, 1, 0); PG8_LDB(B1, 1, 1); PG8_SCHED; PG8_LDA(At, 1, 0); PG8_STAGE(PG8_SA(0, 1), a2 + hstepA, voffA);
            PG8_WAIT_V(8); PG8_WAIT_L(0); PG8_BAR; PG8_MMA(0, 0, At, B0); PG8_MMA(0, 1, At, B1); PG8_BAR; PG8_SCHED;
            PG8_LDA(At, 1, 1); PG8_STAGE(PG8_SB(1, 0), b3, voffB); PG8_STAGE(PG8_SB(1, 1), b3 + hstepB, voffB); PG8_STAGE(PG8_SA(1, 0), a3, voffA);
            PG8_WAIT_V(8); PG8_WAIT_L(0); PG8_BAR; PG8_MMA(1, 0, At, B0); PG8_MMA(1, 1, At, B1); PG8_BAR; PG8_SCHED;
            } else {
            PG8_LDB(B0, 0, 0); PG8_SCHED; PG8_LDA(At, 0, 0); PG8_STAGE(PG8_SA(1, 1), a1 + hstepA, voffA);
            PG8_WAIT_L(8); PG8_BAR; PG8_WAIT_L(0); PG8_MMA(0, 0, At, B0); PG8_BAR; PG8_SCHED;
            PG8_LDB(B1, 0, 1); PG8_STAGE(PG8_SB(0, 0), b2, voffB);
            PG8_BAR; PG8_WAIT_L(0); PG8_MMA(0, 1, At, B1); PG8_BAR;
            PG8_LDA(At, 0, 1); PG8_STAGE(PG8_SA(0, 0), a2, voffA);
            PG8_BAR; PG8_WAIT_L(0); PG8_MMA(1, 0, At, B0); PG8_BAR; PG8_SCHED;
            PG8_STAGE(PG8_SB(0, 1), b2 + hstepB, voffB);
            PG8_WAIT_V(6); PG8_BAR; PG8_MMA(1, 1, At, B1); PG8_BAR;
            PG8_LDB(B0, 1, 0); PG8_SCHED; PG8_LDA(At, 1, 0); PG8_STAGE(PG8_SA(0, 1), a2 + hstepA, voffA);
            PG8_WAIT_L(8); PG8_BAR; PG8_WAIT_L(0); PG8_MMA(0, 0, At, B0); PG8_BAR; PG8_SCHED;
            PG8_LDB(B1, 1, 1); PG8_STAGE(PG8_SB(1, 0), b3, voffB);
            PG8_BAR; PG8_WAIT_L(0); PG8_MMA(0, 1, At, B1); PG8_BAR;
            PG8_LDA(At, 1, 1); PG8_STAGE(PG8_SA(1, 0), a3, voffA);
            PG8_BAR; PG8_WAIT_L(0); PG8_MMA(1, 0, At, B0); PG8_BAR; PG8_SCHED;
            PG8_STAGE(PG8_SB(1, 1), b3 + hstepB, voffB);
            PG8_WAIT_V(6); PG8_BAR; PG8_MMA(1, 1, At, B1); PG8_BAR;
            }
        }
        if constexpr (ALIGN_EPI) { if (wr == 0) PG8_BAR; }
        if constexpr (!Epi::AFTER_DRAIN) { E(acc, cur, wr, wc, fr, fq, epre); S.done(cur); if (has_next) E.prefetch(epre, nxt, wr, fr); }
        if (!has_next) break;
#pragma unroll
        for (int a = 0; a < 2; ++a)
#pragma unroll
            for (int b = 0; b < 2; ++b)
#pragma unroll
                for (int m = 0; m < 4; ++m)
#pragma unroll
                    for (int n = 0; n < 2; ++n) acc[a][b][m][n] = (f32x4){0.f, 0.f, 0.f, 0.f};
        cur = nxt; cA = nA; cB = nB; ++ui;
        if constexpr (ALIGN_EPI) { if (wr == 1) PG8_BAR; }
    }
    PG8_WAIT_V(0);
    if constexpr (!ALIGN_EPI) { if (wr == 0) PG8_BAR; }
    PG8_BAR;
    if constexpr (Epi::AFTER_DRAIN) { E.fused(acc, cur, wr, wc, fr, fq, lds, wid, lane); S.done(cur); }
#undef PG8_SA
#undef PG8_SB
#undef PG8_STAGE
#undef PG8_LDA
#undef PG8_LDB
#undef PG8_MMA
#undef PG8_WAIT_V
#undef PG8_WAIT_L
#undef PG8_BAR
#undef PG8_SCHED
}
}
namespace pg8 {
__device__ __forceinline__ float rstd_of(float ss) { return __builtin_amdgcn_rsqf(ss * (1.0f / 1024.0f) + 1e-6f); }
__device__ __forceinline__ float silu_mul(float g, float u) { return g * __builtin_amdgcn_rcpf(1.0f + __builtin_amdgcn_exp2f(-1.4426950408889634f * g)) * u; }
template <bool SS> struct EpiSwiGLU {
    static constexpr bool PERM = true, AFTER_DRAIN = false;
    bf16_t* O; int ldc; const float* ss;
    __device__ __forceinline__ void prefetch(float (&pre)[8], const Unit& u, int wr, int fr) const {
        const int row0 = u.pm * BM + wr * 64 + fr;
#pragma unroll
        for (int i = 0; i < 8; ++i) pre[i] = SS ? ss[row0 + (i >> 2) * HALF + (i & 3) * 16] : 1.f;
    }
    __device__ __forceinline__ void operator()(const f32x4 (&acc)[2][2][4][2], const Unit& u, int wr, int wc, int fr, int fq, const float (&pre)[8]) const {
        const int row0 = u.pm * BM + wr * 64 + fr, col0 = u.pn * HALF + wc * 32 + 8 * fq;
        float rsv[8];
#pragma unroll
        for (int i = 0; i < 8; ++i) rsv[i] = pre[i];
        if (SS) {
#pragma unroll
            for (int i = 0; i < 8; ++i) rsv[i] = rstd_of(rsv[i]); }
#pragma unroll
        for (int ai = 0; ai < 2; ++ai)
#pragma unroll
            for (int m = 0; m < 4; ++m) {
                const int row = row0 + ai * HALF + m * 16; const float rs = rsv[ai * 4 + m];
                typedef float f32x2 __attribute__((ext_vector_type(2)));
                u32x4 w;
#pragma unroll
                for (int n = 0; n < 2; ++n) {
                    const f32x4 gq = acc[ai][0][m][n], uq = acc[ai][1][m][n];
#pragma unroll
                    for (int hh = 0; hh < 2; ++hh) {
                        f32x2 g = (f32x2){gq[2 * hh], gq[2 * hh + 1]}, uu = (f32x2){uq[2 * hh], uq[2 * hh + 1]};
                        if (SS) { g = g * rs; uu = uu * rs; }
                        const f32x2 t = g * (-1.4426950408889634f);
                        f32x2 e; e.x = __builtin_amdgcn_exp2f(t.x); e.y = __builtin_amdgcn_exp2f(t.y);
                        const f32x2 d = e + 1.0f;
                        f32x2 r; r.x = __builtin_amdgcn_rcpf(d.x); r.y = __builtin_amdgcn_rcpf(d.y);
                        const f32x2 o = (g * uu) * r;
                        w[2 * n + hh] = cvt_pk_bf16(o.x, o.y);
                    }
                }
                st16_wt(O, (unsigned)((((size_t)u.pm * (ldc >> 6) + (col0 >> 6)) * 256 + (row & 255)) * 64 + (col0 & 63)) * 2u, w);
            }
    }
};
template <bool SS> struct EpiScaleBf16 {
    static constexpr bool PERM = true, AFTER_DRAIN = false;
    bf16_t* O; int ldc; const float* ss;
    __device__ __forceinline__ void prefetch(float (&pre)[8], const Unit& u, int wr, int fr) const {
        const int row0 = u.pm * BM + wr * 64 + fr;
#pragma unroll
        for (int i = 0; i < 8; ++i) pre[i] = SS ? ss[row0 + (i >> 2) * HALF + (i & 3) * 16] : 1.f;
    }
    __device__ __forceinline__ void operator()(const f32x4 (&acc)[2][2][4][2], const Unit& u, int wr, int wc, int fr, int fq, const float (&pre)[8]) const {
        const int row0 = u.pm * BM + wr * 64 + fr, col0 = u.pn * BM + wc * 32 + 8 * fq;
        float rsv[8];
#pragma unroll
        for (int i = 0; i < 8; ++i) rsv[i] = pre[i];
        if (SS) {
#pragma unroll
            for (int i = 0; i < 8; ++i) rsv[i] = rstd_of(rsv[i]); }
#pragma unroll
        for (int ai = 0; ai < 2; ++ai)
#pragma unroll
            for (int m = 0; m < 4; ++m) {
                const int row = row0 + ai * HALF + m * 16; const float rs = rsv[ai * 4 + m];
#pragma unroll
                for (int bj = 0; bj < 2; ++bj) {
                    const f32x4 v0 = acc[ai][bj][m][0] * rs, v1 = acc[ai][bj][m][1] * rs; u32x4 w;
                    w.x = cvt_pk_bf16(v0[0], v0[1]); w.y = cvt_pk_bf16(v0[2], v0[3]); w.z = cvt_pk_bf16(v1[0], v1[1]); w.w = cvt_pk_bf16(v1[2], v1[3]);
                    *(u32x4*)(O + (size_t)row * ldc + col0 + bj * HALF) = w;
                }
            }
    }
};
template <int MODE> struct EpiResid {
    static constexpr bool PERM = true, AFTER_DRAIN = false;
    const float* base; float* out; bf16_t* xb; float* ssn;
    __device__ __forceinline__ void prefetch(float (&)[8], const Unit&, int, int) const {}
    __device__ __forceinline__ void operator()(const f32x4 (&acc)[2][2][4][2], const Unit& u, int wr, int wc, int fr, int fq, const float (&)[8]) const {
        const int row0 = u.pm * BM + wr * 64 + fr, col0 = u.pn * BM + wc * 32 + 8 * fq;
        f32x4 pre[2][2][2]; u32x4 preb[2][2];
#define EPR_LOAD(slot, it) do { const size_t off_ = (size_t)(row0 + ((it) >> 2) * HALF + ((it) & 3) * 16) * 1024 + col0; \
        if (MODE == 0) { pre[slot][0][0] = __builtin_nontemporal_load((const f32x4*)(base + off_)); pre[slot][0][1] = __builtin_nontemporal_load((const f32x4*)(base + off_ + 4)); pre[slot][1][0] = __builtin_nontemporal_load((const f32x4*)(base + off_ + HALF)); pre[slot][1][1] = __builtin_nontemporal_load((const f32x4*)(base + off_ + HALF + 4)); } \
        else { preb[slot][0] = *(const u32x4*)(xb + off_); preb[slot][1] = *(const u32x4*)(xb + off_ + HALF); } } while (0)
        EPR_LOAD(0, 0); EPR_LOAD(1, 1);
        float sacc[8];
#pragma unroll
        for (int it = 0; it < 8; ++it) {
            const int ai = it >> 2, m = it & 3, row = row0 + ai * HALF + m * 16; float s = 0.f;
            f32x4 v[2][2];
#pragma unroll
            for (int bj = 0; bj < 2; ++bj) {
                f32x4 b0, b1;
                if (MODE == 0) { b0 = pre[it & 1][bj][0]; b1 = pre[it & 1][bj][1]; }
                else { const u32x4 w = preb[it & 1][bj]; b0 = (f32x4){__uint_as_float(w.x << 16), __uint_as_float(w.x & 0xffff0000u), __uint_as_float(w.y << 16), __uint_as_float(w.y & 0xffff0000u)};
                       b1 = (f32x4){__uint_as_float(w.z << 16), __uint_as_float(w.z & 0xffff0000u), __uint_as_float(w.w << 16), __uint_as_float(w.w & 0xffff0000u)}; }
                v[bj][0] = b0 + acc[ai][bj][m][0]; v[bj][1] = b1 + acc[ai][bj][m][1]; }
            if (it + 2 < 8) EPR_LOAD(it & 1, it + 2);
#pragma unroll
            for (int bj = 0; bj < 2; ++bj) {
                const size_t off = (size_t)row * 1024 + col0 + bj * HALF; const f32x4 v0 = v[bj][0], v1 = v[bj][1];
                if (MODE == 2) { *(f32x4*)(out + off) = v0; *(f32x4*)(out + off + 4) = v1; }
                else {
                    s += (v0[0] * v0[0] + v0[1] * v0[1]) + (v0[2] * v0[2] + v0[3] * v0[3]) + (v1[0] * v1[0] + v1[1] * v1[1]) + (v1[2] * v1[2] + v1[3] * v1[3]);
                    u32x4 w; w.x = cvt_pk_bf16(v0[0], v0[1]); w.y = cvt_pk_bf16(v0[2], v0[3]); w.z = cvt_pk_bf16(v1[0], v1[1]); w.w = cvt_pk_bf16(v1[2], v1[3]);
                    st16_wt(xb, (unsigned)off * 2u, w);
                }
            }
            sacc[it] = s;
        }
#undef EPR_LOAD
        if (MODE != 2) {
#pragma unroll
            for (int it = 0; it < 8; ++it) { float s = sacc[it]; s += __shfl_xor(s, 16); s += __shfl_xor(s, 32); if (fq == 0) unsafeAtomicAdd(ssn + row0 + (it >> 2) * HALF + (it & 3) * 16, s); }
        }
    }
};
struct ExtraOrder {
    int c, c0, nN, n;
    __device__ bool next(int i, Unit& u) const { const int k = c - c0; if (i > 0 || k < 0 || k >= n) return false; u.pm = k / nN; u.pn = k % nN; return true; }
    __device__ __forceinline__ void a_ready(const Unit&) const {}
    __device__ __forceinline__ void done(const Unit&) const {}
};
}

constexpr int BATCH = 8, SEQ = 2048, DM = 1024, M = BATCH * SEQ, DFF = 2816, INC = 1536, MEML = 256, MROWS = BATCH * MEML;
constexpr int NWAVES = 8, NTHR = 512;
#define LAS __attribute__((address_space(3)))
typedef unsigned short bf16;
typedef unsigned u32x4 __attribute__((ext_vector_type(4)));
typedef unsigned u32x2 __attribute__((ext_vector_type(2)));
typedef float f32x4 __attribute__((ext_vector_type(4)));
typedef float f32x16 __attribute__((ext_vector_type(16)));
typedef short bf16x8 __attribute__((ext_vector_type(8)));
typedef short s16x4 __attribute__((ext_vector_type(4)));
constexpr size_t MiB = 1u << 20;
constexpr size_t WS_CTL = 512 * 1024, CTL_BYTES = 64 * 1024;
constexpr size_t WS_SS0 = 0, WS_SS1 = 64 * 1024, WS_SS2 = 128 * 1024, WS_SSM = 192 * 1024;
constexpr size_t WS_W1GU = 1 * MiB, WS_W1D = 12 * MiB, WS_W2GU = 18 * MiB, WS_W2D = 29 * MiB, WS_WIN = 35 * MiB, WS_WOUT = 38 * MiB, WS_WMKV = 40 * MiB;
constexpr size_t WS_XB = 41 * MiB, WS_ACT = 73 * MiB, WS_PROJ = 73 * MiB, WS_Y = 121 * MiB, WS_MEMB = 161 * MiB, WS_MKV = 165 * MiB, WS_END = 167 * MiB;
static_assert(WS_W1GU + (size_t)2 * DFF * DM * 2 <= WS_W1D && WS_W1D + (size_t)DM * DFF * 2 <= WS_W2GU && WS_W2GU + (size_t)2 * DFF * DM * 2 <= WS_W2D && WS_W2D + (size_t)DM * DFF * 2 <= WS_WIN, "ws map");
static_assert(WS_WIN + (size_t)INC * DM * 2 <= WS_WOUT && WS_WOUT + (size_t)DM * DM * 2 <= WS_WMKV && WS_WMKV + (size_t)512 * DM * 2 <= WS_XB, "ws map");
static_assert(WS_ACT + (size_t)M * DFF * 2 <= WS_MEMB && WS_PROJ + (size_t)M * INC * 2 <= WS_Y && WS_Y + (size_t)M * DM * 2 <= WS_MEMB, "ws map");
constexpr int LDS_BYTES = 147456, RING_BYTES = 131072;

typedef float f32x2_t __attribute__((ext_vector_type(2))); typedef __bf16 bf16x2_t __attribute__((ext_vector_type(2)));
__device__ __forceinline__ unsigned pk2(float lo, float hi) { f32x2_t v = {lo, hi}; bf16x2_t b = __builtin_convertvector(v, bf16x2_t); return __builtin_bit_cast(unsigned, b); }
__device__ __forceinline__ float bflo(unsigned w) { return __uint_as_float(w << 16); }
__device__ __forceinline__ float bfhi(unsigned w) { return __uint_as_float(w & 0xffff0000u); }
__device__ __forceinline__ float wave_sum(float v) {
    v += __builtin_bit_cast(float, __builtin_amdgcn_update_dpp(0, __builtin_bit_cast(int, v), 0xB1, 0xf, 0xf, true));
    v += __builtin_bit_cast(float, __builtin_amdgcn_update_dpp(0, __builtin_bit_cast(int, v), 0x4E, 0xf, 0xf, true));
    v += __builtin_bit_cast(float, __builtin_amdgcn_update_dpp(0, __builtin_bit_cast(int, v), 0x141, 0xf, 0xf, true));
    v += __builtin_bit_cast(float, __builtin_amdgcn_update_dpp(0, __builtin_bit_cast(int, v), 0x140, 0xf, 0xf, true));
    v += __builtin_bit_cast(float, __builtin_amdgcn_update_dpp(0, __builtin_bit_cast(int, v), 0x142, 0xa, 0xf, true));
    v += __builtin_bit_cast(float, __builtin_amdgcn_update_dpp(0, __builtin_bit_cast(int, v), 0x143, 0xc, 0xf, true));
    return __builtin_bit_cast(float, __builtin_amdgcn_readlane(__builtin_bit_cast(int, v), 63));
}
__device__ __forceinline__ void transpose_item(const float* W, int K, int N, bf16* WT, int mode, const float* g, float scale, LAS float* scr, int item, int lane) {
    const int nblk = N / 64, kb = item / nblk, nb = item % nblk, k0 = 64 * kb, n0 = 64 * nb;
    const int kr = lane >> 4, n4 = (lane & 15) * 4;
    f32x4 v[16];
#pragma unroll
    for (int i = 0; i < 16; ++i) v[i] = __builtin_nontemporal_load((const f32x4*)(W + (size_t)(k0 + kr + 4 * i) * N + n0 + n4));
#pragma unroll
    for (int i = 0; i < 16; ++i) { const float gv = g ? g[k0 + kr + 4 * i] * scale : scale; LAS float* d = scr + (kr + 4 * i) * 65 + n4;
        d[0] = v[i].x * gv; d[1] = v[i].y * gv; d[2] = v[i].z * gv; d[3] = v[i].w * gv; }
    asm volatile("s_waitcnt lgkmcnt(0)" ::: "memory");
    const int rb = mode == 0 ? n0 : mode == 3 ? (n0 < 768 ? n0 : n0 < 1280 ? n0 + 256 : n0 - 512) : (256 * (n0 >> 7) + (n0 & 127) + (mode == 2 ? 128 : 0));
    const int c = lane & 7;
#pragma unroll
    for (int j = 0; j < 8; ++j) { const int n = (lane >> 3) + 8 * j; const LAS float* s = scr + (8 * c) * 65 + n;
        u32x4 o; o.x = pk2(s[0 * 65], s[1 * 65]); o.y = pk2(s[2 * 65], s[3 * 65]); o.z = pk2(s[4 * 65], s[5 * 65]); o.w = pk2(s[6 * 65], s[7 * 65]);
        const int row = rb + n; *(u32x4*)(WT + (((size_t)(row >> 8) * (K >> 6) + (k0 >> 6)) * 256 + (row & 255)) * 64 + 8 * c) = o; }
    asm volatile("s_waitcnt lgkmcnt(0)" ::: "memory");
}
__device__ __forceinline__ void rows4_to_bf16_norm(const float* xrow, bf16* orow, int lane) {
    f32x4 v[4][4];
#pragma unroll
    for (int r = 0; r < 4; ++r)
#pragma unroll
        for (int j = 0; j < 4; ++j) v[r][j] = __builtin_nontemporal_load((const f32x4*)(xrow + (size_t)r * DM) + 64 * j + lane);
#pragma unroll
    for (int r = 0; r < 4; ++r) { float s = 0.f;
#pragma unroll
        for (int j = 0; j < 4; ++j) s += (v[r][j].x * v[r][j].x + v[r][j].y * v[r][j].y) + (v[r][j].z * v[r][j].z + v[r][j].w * v[r][j].w);
        const float rs = __builtin_amdgcn_rsqf(wave_sum(s) * (1.0f / 1024.0f) + 1e-6f);
        u32x2* o8 = (u32x2*)(orow + (size_t)r * DM) + lane;
#pragma unroll
        for (int j = 0; j < 4; ++j) { u32x2 w; w.x = pk2(v[r][j].x * rs, v[r][j].y * rs); w.y = pk2(v[r][j].z * rs, v[r][j].w * rs); o8[64 * j] = w; } }
}
namespace att {
constexpr int ROWB = 144, KOFF = 0, VOFF = 256 * ROWB;
constexpr float LOG2E = 1.4426950408889634f;
__device__ __forceinline__ int crow(int r, int h) { return (r & 3) + 8 * (r >> 2) + 4 * h; }
__device__ __forceinline__ void sincos_rev(float ang, float& s, float& c) {
    const float hi = ang * 0.15915493667125702f, lo = __builtin_fmaf(ang, 0.15915493667125702f, -hi) + ang * 6.4206382432985265e-09f;
    const float r = __builtin_amdgcn_fractf(hi) + lo; s = __builtin_amdgcn_sinf(r); c = __builtin_amdgcn_cosf(r);
}
__device__ __forceinline__ float inv_freq(int i) {
    return i == 0 ? 1.0f : i == 1 ? 0.19392274474868576f : i == 2 ? 0.03760603093086393f : i == 3 ? 0.007292664737217109f : i == 4 ? 0.001414213562373095f : i == 5 ? 0.0002742481756762073f : i == 6 ? 5.318295896944988e-05f : 1.031338537721246e-05f;
}
__device__ __forceinline__ void kv_issue(u32x4 (&kr)[4], u32x4 (&vr)[4], const bf16* Ksrc, const bf16* Vsrc, int ld, int row_lo, int tid) {
    const int key = tid >> 1, half = tid & 1;
#pragma unroll
    for (int c = 0; c < 4; ++c) { kr[c] = (u32x4){0u, 0u, 0u, 0u}; vr[c] = (u32x4){0u, 0u, 0u, 0u}; }
    if (key >= row_lo) {
        const u32x4* kp = (const u32x4*)(Ksrc + (long)key * ld + 32 * half); const u32x4* vp = (const u32x4*)(Vsrc + (long)key * ld + 32 * half);
#pragma unroll
        for (int c = 0; c < 4; ++c) { kr[c] = kp[c]; vr[c] = vp[c]; }
    }
}
template <bool ROPE> __device__ __forceinline__ void kv_finish(LAS unsigned char* lds, const u32x4 (&kr)[4], const u32x4 (&vr)[4], const float* gk, const float* gq, float p, int tid) {
    const int key = tid >> 1, half = tid & 1;
    f32x4 gkv[8], gqv[8];
#pragma unroll
    for (int c = 0; c < 8; ++c) { gkv[c] = *(const f32x4*)(gk + 32 * half + 4 * c); gqv[c] = *(const f32x4*)(gq + 32 * half + 4 * c); }
    LAS unsigned char* vdst = lds + VOFF + key * ROWB + 64 * half;
#pragma unroll
    for (int c = 0; c < 4; ++c) *(LAS u32x4*)(vdst + 16 * c) = vr[c];
    float f[32]; float ss = 0.f;
#pragma unroll
    for (int c = 0; c < 4; ++c)
#pragma unroll
        for (int w = 0; w < 4; ++w) { const unsigned x = kr[c][w]; f[8 * c + 2 * w] = bflo(x); f[8 * c + 2 * w + 1] = bfhi(x); }
#pragma unroll
    for (int i = 0; i < 32; ++i) ss += f[i] * f[i];
    ss += __shfl_xor(ss, 1);
    const float rs = __builtin_amdgcn_rsqf(ss * (1.0f / 64.0f) + 1e-6f);
#pragma unroll
    for (int i = 0; i < 32; ++i) { const float gkk = gkv[i >> 2][i & 3], gqq = gqv[i >> 2][i & 3]; f[i] *= rs * ((ROPE && i < 16) ? (half == 0 ? gkk : gkk * gqq) : gkk * gqq); }
    if (ROPE) {
        if (half == 0) {
#pragma unroll
            for (int i = 0; i < 8; ++i) { float s, c; sincos_rev(p * inv_freq(i), s, c); const float x1 = f[i], x2 = f[8 + i]; f[i] = x1 * c - x2 * s; f[8 + i] = x2 * c + x1 * s; }
        }
    }
    LAS unsigned char* kdst = lds + KOFF + key * ROWB + 64 * half;
#pragma unroll
    for (int c = 0; c < 4; ++c) { u32x4 w; w.x = pk2(f[8 * c], f[8 * c + 1]); w.y = pk2(f[8 * c + 2], f[8 * c + 3]); w.z = pk2(f[8 * c + 4], f[8 * c + 5]); w.w = pk2(f[8 * c + 6], f[8 * c + 7]); *(LAS u32x4*)(kdst + 16 * c) = w; }
}
__device__ __forceinline__ void q_issue(u32x4 (&raw)[4], const bf16* Qrow0, int ldq, int lane) {
    const int ql = lane & 31, h = lane >> 5;
#pragma unroll
    for (int ds = 0; ds < 4; ++ds) raw[ds] = *(const u32x4*)(Qrow0 + (long)ql * ldq + 16 * ds + 8 * h);
}
template <int NKT, bool SWA> __device__ __forceinline__ void attn_wave(LAS unsigned char* lds, const u32x4 (&raw)[4], const f32x4 (&g0)[2], float p_, float sink2, int t0, bool blk0, bf16* Orow0, int ldo, int lane) {
    const int ql = lane & 31, h = lane >> 5;
    float f[4][8]; float ss = 0.f;
#pragma unroll
    for (int ds = 0; ds < 4; ++ds)
#pragma unroll
        for (int w = 0; w < 4; ++w) { const unsigned x = raw[ds][w]; f[ds][2 * w] = bflo(x); f[ds][2 * w + 1] = bfhi(x); }
#pragma unroll
    for (int ds = 0; ds < 4; ++ds)
#pragma unroll
        for (int i = 0; i < 8; ++i) ss += f[ds][i] * f[ds][i];
    ss += __shfl_xor(ss, 32);
    const float rs = __builtin_amdgcn_rsqf(ss * (1.0f / 64.0f) + 1e-6f) * (0.125f * LOG2E);
#pragma unroll
    for (int ds = 0; ds < 4; ++ds)
#pragma unroll
        for (int i = 0; i < 8; ++i) f[ds][i] *= rs;
    if (SWA) {
#pragma unroll
        for (int i = 0; i < 8; ++i) f[0][i] *= g0[i >> 2][i & 3];
#pragma unroll
        for (int i = 0; i < 8; ++i) { float s, c; sincos_rev(p_ * inv_freq(i), s, c); const float other = __shfl_xor(f[0][i], 32); f[0][i] = f[0][i] * c + (h ? other : -other) * s; }
    }
    bf16x8 qf[4];
#pragma unroll
    for (int ds = 0; ds < 4; ++ds) { u32x4 w; w.x = pk2(f[ds][0], f[ds][1]); w.y = pk2(f[ds][2], f[ds][3]); w.z = pk2(f[ds][4], f[ds][5]); w.w = pk2(f[ds][6], f[ds][7]); qf[ds] = __builtin_bit_cast(bf16x8, w); }
    constexpr float SOFF = 8.0f;
    f32x16 p[NKT];
#pragma unroll
    for (int kt = 0; kt < NKT; ++kt) {
#pragma unroll
        for (int r = 0; r < 16; ++r) p[kt][r] = -SOFF;
        const LAS unsigned char* kb = lds + KOFF + (32 * (t0 + kt) + ql) * ROWB + 16 * h;
#pragma unroll
        for (int ds = 0; ds < 4; ++ds) { const bf16x8 a = *(const LAS bf16x8*)(kb + 32 * ds); p[kt] = __builtin_amdgcn_mfma_f32_32x32x16_bf16(a, qf[ds], p[kt], 0, 0, 0); }
    }
    const float NEG = -INFINITY;
    if (SWA) {
#pragma unroll
        for (int r = 0; r < 16; ++r) { const int kvl = crow(r, h); if (kvl <= ql) p[0][r] = NEG; if (kvl > ql) p[NKT - 1][r] = NEG; }
        if (blk0) {
#pragma unroll
            for (int kt = 0; kt < NKT; ++kt) if (t0 + kt < 4) {
#pragma unroll
                for (int r = 0; r < 16; ++r) p[kt][r] = NEG; }
        }
    }
    float l = 0.f;
#pragma unroll
    for (int kt = 0; kt < NKT; ++kt)
#pragma unroll
        for (int r = 0; r < 16; ++r) { p[kt][r] = __builtin_amdgcn_exp2f(p[kt][r]); l += p[kt][r]; }
    l += __shfl_xor(l, 32);
    if (SWA) l += __builtin_amdgcn_exp2f(sink2 - SOFF);
    const float inv = 1.0f / l;
    f32x16 o[2];
#pragma unroll
    for (int db = 0; db < 2; ++db)
#pragma unroll
        for (int r = 0; r < 16; ++r) o[db][r] = 0.f;
    const LAS unsigned char* vb = lds + VOFF + (4 * h + ((lane & 15) >> 2)) * ROWB + (16 * ((lane >> 4) & 1) + 4 * (lane & 3)) * 2;
#pragma unroll
    for (int kt = 0; kt < NKT; ++kt)
#pragma unroll
        for (int s = 0; s < 2; ++s) {
            u32x4 w; w.x = pk2(p[kt][8 * s], p[kt][8 * s + 1]); w.y = pk2(p[kt][8 * s + 2], p[kt][8 * s + 3]); w.z = pk2(p[kt][8 * s + 4], p[kt][8 * s + 5]); w.w = pk2(p[kt][8 * s + 6], p[kt][8 * s + 7]);
            const bf16x8 pf = __builtin_bit_cast(bf16x8, w);
            const LAS unsigned char* vp = vb + (32 * (t0 + kt) + 16 * s) * ROWB;
#pragma unroll
            for (int db = 0; db < 2; ++db) {
                const s16x4 lo = __builtin_bit_cast(s16x4, __builtin_amdgcn_ds_read_tr16_b64_v4i16((LAS s16x4*)(vp + 64 * db)));
                const s16x4 hi = __builtin_bit_cast(s16x4, __builtin_amdgcn_ds_read_tr16_b64_v4i16((LAS s16x4*)(vp + 64 * db + 8 * ROWB)));
                const bf16x8 a = (bf16x8){lo[0], lo[1], lo[2], lo[3], hi[0], hi[1], hi[2], hi[3]};
                o[db] = __builtin_amdgcn_mfma_f32_32x32x16_bf16(a, pf, o[db], 0, 0, 0);
            }
        }
    bf16* orow = Orow0 + (long)ql * ldo;
#pragma unroll
    for (int db = 0; db < 2; ++db)
#pragma unroll
        for (int g = 0; g < 4; ++g) { u32x2 w; w.x = pk2(o[db][4 * g] * inv, o[db][4 * g + 1] * inv); w.y = pk2(o[db][4 * g + 2] * inv, o[db][4 * g + 3] * inv);
            *(u32x2*)(orow + 32 * db + 8 * g + 4 * h) = w; }
}
}

__device__ __forceinline__ void conv_unit(LAS unsigned char* lds, const bf16* proj, int b, int tt, const float* w_dw, const float* b_dw, const float* g_ln, const float* b_ln, bf16* y, int tid) {
    LAS float* H = (LAS float*)lds;
    const int t0 = tt * 64;
    {
        u32x4 av[6], gv[6];
#pragma unroll
        for (int k = 0; k < 6; ++k) {
            const int idx = tid + k * NTHR, tk = idx >> 5, ch = idx & 31, t = t0 - 30 + tk;
            av[k] = (u32x4){0u, 0u, 0u, 0u}; gv[k] = av[k];
            if (idx < 94 * 32 && t >= 0) { const bf16* pp = proj + (size_t)(b * SEQ + t) * INC + 1024 + ch * 8; av[k] = *(const u32x4*)pp; gv[k] = *(const u32x4*)(pp + 256); }
        }
#pragma unroll
        for (int k = 0; k < 6; ++k) {
            const int idx = tid + k * NTHR, tk = idx >> 5, ch = idx & 31;
            float af[8], gf[8];
#pragma unroll
            for (int w = 0; w < 4; ++w) { af[2 * w] = bflo(av[k][w]); af[2 * w + 1] = bfhi(av[k][w]); gf[2 * w] = bflo(gv[k][w]); gf[2 * w + 1] = bfhi(gv[k][w]); }
#pragma unroll
            for (int i = 0; i < 8; ++i) af[i] = af[i] * __builtin_amdgcn_rcpf(1.0f + __builtin_amdgcn_exp2f(-1.4426950408889634f * gf[i]));
            if (idx < 94 * 32) { *(LAS f32x4*)(H + tk * 256 + ch * 8) = (f32x4){af[0], af[1], af[2], af[3]}; *(LAS f32x4*)(H + tk * 256 + ch * 8 + 4) = (f32x4){af[4], af[5], af[6], af[7]}; }
        }
    }
    __syncthreads();
    {
        const int cp = tid & 127, tg = tid >> 7;
        f32x2_t w2[31];
#pragma unroll
        for (int j = 0; j < 31; ++j) w2[j] = *(const f32x2_t*)(w_dw + j * 256 + 2 * cp);
        const f32x2_t bias2 = *(const f32x2_t*)(b_dw + 2 * cp);
        f32x2_t outv[16];
#pragma unroll
        for (int ck = 0; ck < 2; ++ck) {
            f32x2_t hv[38];
#pragma unroll
            for (int i = 0; i < 38; ++i) hv[i] = *(const LAS f32x2_t*)(H + (tg * 16 + ck * 8 + i) * 256 + 2 * cp);
#pragma unroll
            for (int k = 0; k < 8; ++k) { f32x2_t acc2 = bias2;
#pragma unroll
                for (int j = 0; j < 31; ++j) acc2 = __builtin_elementwise_fma(w2[j], hv[k + j], acc2);
                outv[ck * 8 + k] = acc2; }
        }
        __syncthreads();
#pragma unroll
        for (int k = 0; k < 16; ++k) *(LAS f32x2_t*)(H + (tg * 16 + k) * 256 + 2 * cp) = outv[k];
        __syncthreads();
    }
    const int wv = tid >> 6, lane = tid & 63;
    const f32x4 gg = *(const f32x4*)(g_ln + 4 * lane), bb = *(const f32x4*)(b_ln + 4 * lane);
#pragma unroll
    for (int k = 0; k < 8; ++k) {
        const int tok = wv * 8 + k; f32x4 v = *(LAS f32x4*)(H + tok * 256 + 4 * lane);
        const float mean = wave_sum((v.x + v.y) + (v.z + v.w)) * (1.0f / 256.0f);
        v = v - mean;
        const float var = wave_sum((v.x * v.x + v.y * v.y) + (v.z * v.z + v.w * v.w)) * (1.0f / 256.0f);
        const float rs = __builtin_amdgcn_rsqf(var + 1e-6f);
        v = v * rs * gg + bb;
        float o[4];
#pragma unroll
        for (int i = 0; i < 4; ++i) o[i] = v[i] * __builtin_amdgcn_rcpf(1.0f + __builtin_amdgcn_exp2f(-1.4426950408889634f * v[i]));
        u32x2 pw; pw.x = pk2(o[0], o[1]); pw.y = pk2(o[2], o[3]);
        *(u32x2*)(y + (size_t)(b * SEQ + t0 + tok) * DM + 512 + 4 * lane) = pw;
    }
    __syncthreads();
}

#define XB_TMO      128
#define XB_XCNT(j)  (256  + 64 * (j))
#define XB_XSUB(j)  (1280 + 64 * (j))
#define XB_XGEN(j)  (2304 + 64 * (j))
#define XB_TOP      3328
#define XB_TOPGEN   3392
#define XCD_BAR_WORDS 3456
#define XB_SPIN_CAP (1u << 18)

__device__ __forceinline__ unsigned xb_ld(unsigned* p)              { return __hip_atomic_load(p, __ATOMIC_RELAXED, __HIP_MEMORY_SCOPE_AGENT); }
__device__ __forceinline__ unsigned xb_add(unsigned* p, unsigned v) { return __hip_atomic_fetch_add(p, v, __ATOMIC_RELAXED, __HIP_MEMORY_SCOPE_AGENT); }
__device__ __forceinline__ unsigned xb_xcc_id() { return (unsigned)__builtin_amdgcn_s_getreg((3 << 11) | 20) & 0xFu; }
#define XB_SPIN(cond, bar) do { unsigned _sp = 0; while (cond) { __builtin_amdgcn_s_sleep(1); \
    if ((++_sp & 255u) == 0u) { if (xb_ld(&(bar)[XB_TMO])) break; if (_sp > XB_SPIN_CAP) { atomicAdd(&(bar)[XB_TMO], 1u); break; } } } } while (0)

struct XcdBarrier {
    unsigned* bar; unsigned x;
    volatile LAS unsigned* st;
};

__device__ __forceinline__ XcdBarrier xcd_barrier_post(unsigned* bar, volatile LAS unsigned* st) {
    XcdBarrier b; b.bar = bar; b.x = xb_xcc_id(); b.st = st;
    if (threadIdx.x == 0) (void)xb_add(&bar[XB_XCNT(b.x)], 1u);
    return b;
}
__device__ __forceinline__ void xcd_barrier_complete(unsigned* bar, unsigned x, unsigned& nloc, unsigned& nx) {
    const unsigned G = gridDim.x * gridDim.y * gridDim.z;
    unsigned sum, cnt, mine, sp = 0u;
    for (;;) {
        sum = 0u; cnt = 0u; mine = 0u;
#pragma unroll
        for (unsigned j = 0; j < 16; ++j) { const unsigned c = xb_ld(&bar[XB_XCNT(j)]); sum += c; cnt += (c > 0u) ? 1u : 0u; mine = (j == x) ? c : mine; }
        if (sum == G) break;
        __builtin_amdgcn_s_sleep(1);
        if ((++sp & 255u) == 0u) { if (xb_ld(&bar[XB_TMO])) break; if (sp > XB_SPIN_CAP) { atomicAdd(&bar[XB_TMO], 1u); break; } }
    }
    nloc = mine > 0u ? mine : 1u; nx = cnt > 0u ? cnt : 1u;
}

__device__ __forceinline__ void xcd_barrier(const XcdBarrier& b) {
    asm volatile("s_waitcnt vmcnt(0)" ::: "memory");
    __syncthreads();
    if (threadIdx.x == 0) {
        unsigned* bar = b.bar;
        __builtin_amdgcn_s_waitcnt(0);
        unsigned nloc = b.st[0], nx = b.st[1];
        if (nloc == 0u) { xcd_barrier_complete(bar, b.x, nloc, nx); b.st[0] = nloc; b.st[1] = nx; }
        const unsigned old = xb_add(&bar[XB_XSUB(b.x)], 1u);
        const unsigned gen = old / nloc;
        if (old + 1u == (gen + 1u) * nloc) {
            __builtin_amdgcn_fence(__ATOMIC_RELEASE, "agent");
            asm volatile("s_waitcnt vmcnt(0)" ::: "memory");
            const unsigned og = xb_add(&bar[XB_TOP], 1u);
            const unsigned tg = og / nx;
            if (og + 1u == (tg + 1u) * nx) xb_add(&bar[XB_TOPGEN], 1u);
            else XB_SPIN(xb_ld(&bar[XB_TOPGEN]) == tg, bar);
            __builtin_amdgcn_fence(__ATOMIC_ACQUIRE, "agent");
            xb_add(&bar[XB_XGEN(b.x)], 1u);
            asm volatile("s_waitcnt vmcnt(0)" ::: "memory");
        } else {
            XB_SPIN(xb_ld(&bar[XB_XGEN(b.x)]) == gen, bar);
            __builtin_amdgcn_fence(__ATOMIC_ACQUIRE, "agent");
            asm volatile("s_waitcnt vmcnt(0)" ::: "memory");
        }
    }
    __syncthreads();
}

struct Args { const float* in[25]; float* out; unsigned char* ws; int ph_lo, ph_hi, li, pad; };
constexpr int NPHASE = 9;
__global__ void __launch_bounds__(NTHR, 2) fwd_kernel(Args a) {
    extern __shared__ __attribute__((aligned(16))) unsigned char lds_raw[];
    LAS unsigned char* lds = (LAS unsigned char*)lds_raw;
    cg::grid_group grid = cg::this_grid();
    const int tid = threadIdx.x, lane = tid & 63, wave = __builtin_amdgcn_readfirstlane(tid >> 6);
    const int G = gridDim.x, bx = blockIdx.x;
    unsigned char* ws = a.ws;
    const float* x = a.in[0]; const float* mem = a.in[1]; const int* positions = (const int*)a.in[2];
    float* ss0 = (float*)(ws + WS_SS0); float* ss1 = (float*)(ws + WS_SS1); float* ss2 = (float*)(ws + WS_SS2); float* ssm = (float*)(ws + WS_SSM);
    bf16* W1GU = (bf16*)(ws + WS_W1GU); bf16* W1D = (bf16*)(ws + WS_W1D); bf16* W2GU = (bf16*)(ws + WS_W2GU); bf16* W2D = (bf16*)(ws + WS_W2D);
    bf16* WIN = (bf16*)(ws + WS_WIN); bf16* WOUT = (bf16*)(ws + WS_WOUT); bf16* WMKV = (bf16*)(ws + WS_WMKV);
    bf16* XB = (bf16*)(ws + WS_XB); bf16* ACT = (bf16*)(ws + WS_ACT); bf16* PROJ = (bf16*)(ws + WS_PROJ); bf16* Y = (bf16*)(ws + WS_Y);
    bf16* MEMB = (bf16*)(ws + WS_MEMB); bf16* MKV = (bf16*)(ws + WS_MKV);
    const int lo = a.ph_lo, hi = a.ph_hi;
#define IN(k) (lo <= (k) && (k) < hi)
    volatile LAS unsigned* MISC = (volatile LAS unsigned*)(lds + LDS_BYTES - 128);
    if (tid < 32) MISC[tid] = 0u;
    __syncthreads();
    const XcdBarrier bar = xcd_barrier_post((unsigned*)(ws + WS_CTL) + a.li * XCD_BAR_WORDS, MISC + 8);
    if (a.ph_lo < 0) grid.sync();
#define SEAM(k) do { if (IN(k) && IN((k) + 1)) xcd_barrier(bar); } while (0)

    if (IN(0)) {
        LAS float* scr = (LAS float*)(lds + wave * 16640);
        const int gw = bx * NWAVES + wave, NGW = G * NWAVES;
        constexpr int I_GU = (DM / 64) * (DFF / 64), I_D = (DFF / 64) * (DM / 64), I_IN = (DM / 64) * (INC / 64), I_OUT = (DM / 64) * (DM / 64), I_MKV = (DM / 64) * (512 / 64);
        constexpr int NITEMS = 2 * I_GU + I_MKV, NXG = M / 4, NMG = MROWS / 4;
        for (int it = gw; it < NITEMS + NXG + NMG; it += NGW) {
            int r = it;
            if (r < I_GU) { transpose_item(a.in[4], DM, DFF, W1GU, 1, a.in[3], 1.f, scr, r, lane); continue; } r -= I_GU;
            if (r < I_GU) { transpose_item(a.in[5], DM, DFF, W1GU, 2, a.in[3], 1.f, scr, r, lane); continue; } r -= I_GU;
            if (r < I_MKV) { transpose_item(a.in[17], DM, 512, WMKV, 0, a.in[16], 1.f, scr, r, lane); continue; } r -= I_MKV;
            if (r < NXG) { rows4_to_bf16_norm(x + (size_t)r * 4 * DM, XB + (size_t)r * 4 * DM, lane); continue; } r -= NXG;
            rows4_to_bf16_norm(mem + (size_t)r * 4 * DM, MEMB + (size_t)r * 4 * DM, lane);
        }
        for (int i = bx * NTHR + tid; i < M; i += G * NTHR) ss2[i] = 0.f;
        __syncthreads();
    }
    SEAM(0);
    if (IN(1)) {
        for (int i = bx * NTHR + tid; i < M; i += G * NTHR) ss1[i] = 0.f;
        { pg8::Gemm g{XB, W1GU, M, 2 * DFF, DM, 2 * DM, 128, 128, 32768}; pg8::StaticOrder S; S.init(M, 2 * DFF, G, bx); pg8::EpiSwiGLU<false> E{ACT, DFF, nullptr};
          pg8::gemm_phase<pg8::EpiSwiGLU<false>, pg8::StaticOrder, true, true>(lds, g, S, E); }
        { pg8::Gemm g{MEMB, WMKV, MROWS, 512, DM, 2 * DM, 128, 128, 32768}; pg8::ExtraOrder S{bx, G >= 160 ? 128 : 0, 2, 16}; pg8::EpiScaleBf16<false> E{MKV, 512, nullptr};
          pg8::gemm_phase<pg8::EpiScaleBf16<false>, pg8::ExtraOrder, true, true>(lds, g, S, E); }
        {
            const int c0 = G >= 160 ? 144 : 0;
            if (bx >= c0) {
                LAS float* scr = (LAS float*)(lds + wave * 16640);
                constexpr int I_GU = (DM / 64) * (DFF / 64), I_D = (DFF / 64) * (DM / 64), I_IN = (DM / 64) * (INC / 64), I_OUT = (DM / 64) * (DM / 64);
                for (int it = (bx - c0) * NWAVES + wave; it < 2 * I_GU + 2 * I_D + I_IN + I_OUT; it += (G - c0) * NWAVES) {
                    int r = it;
                    if (r < I_D) { transpose_item(a.in[6], DFF, DM, W1D, 0, nullptr, 0.5f, scr, r, lane); continue; } r -= I_D;
                    if (r < I_IN) { transpose_item(a.in[8], DM, INC, WIN, 3, a.in[7], 1.f, scr, r, lane); continue; } r -= I_IN;
                    if (r < I_OUT) { transpose_item(a.in[20], DM, DM, WOUT, 0, nullptr, 1.f, scr, r, lane); continue; } r -= I_OUT;
                    if (r < I_GU) { transpose_item(a.in[22], DM, DFF, W2GU, 1, a.in[21], 1.f, scr, r, lane); continue; } r -= I_GU;
                    if (r < I_GU) { transpose_item(a.in[23], DM, DFF, W2GU, 2, a.in[21], 1.f, scr, r, lane); continue; } r -= I_GU;
                    transpose_item(a.in[24], DFF, DM, W2D, 0, nullptr, 0.5f, scr, r, lane);
                }
            }
        }
    }
    SEAM(1);
    if (IN(2)) {
        pg8::Gemm g{ACT, W1D, M, DM, DFF, 128, 32768, 128, 32768}; pg8::StaticOrder S; S.init(M, DM, G, bx); pg8::EpiResid<0> E{x, nullptr, XB, ss1};
        pg8::gemm_phase<pg8::EpiResid<0>, pg8::StaticOrder, true, true>(lds, g, S, E);
    }
    SEAM(2);
    if (IN(3)) {
        pg8::Gemm g{XB, WIN, M, 1024, DM, 2 * DM, 128, 128, 32768}; pg8::StaticOrder S; S.init(M, 1024, G, bx); pg8::EpiScaleBf16<true> E{PROJ, INC, ss1};
        pg8::gemm_phase<pg8::EpiScaleBf16<true>, pg8::StaticOrder, true, true>(lds, g, S, E);
    }
    SEAM(3);
#define SWA_UNIT(u_) do { const int u = (u_); const int b = u >> 5, g = (u >> 4) & 1, n = u & 15; \
            const long krow0 = (long)b * SEQ + (n - 1) * 128; const int hq = g * 4 + (wave >> 1); const long qrow = (long)b * SEQ + n * 128 + 64 * (wave & 1); \
            u32x4 kr[4], vr[4], raw0[4], raw1[4]; \
            att::kv_issue(kr, vr, PROJ + krow0 * INC + 512 + g * 64, PROJ + krow0 * INC + 640 + g * 64, INC, n == 0 ? 128 : 0, tid); \
            att::q_issue(raw0, PROJ + qrow * INC + hq * 64, INC, lane); att::q_issue(raw1, PROJ + (qrow + 32) * INC + hq * 64, INC, lane); \
            const int kpos = ((tid >> 1) >= (n == 0 ? 128 : 0)) ? positions[krow0 + (tid >> 1)] : 0; const int qp0 = positions[qrow + (lane & 31)], qp1 = positions[qrow + 32 + (lane & 31)]; \
            f32x4 g0[2]; g0[0] = *(const f32x4*)(a.in[9] + 8 * (lane >> 5)); g0[1] = *(const f32x4*)(a.in[9] + 8 * (lane >> 5) + 4); \
            const float sink2 = a.in[11][hq] * att::LOG2E; \
            att::kv_finish<true>(lds, kr, vr, a.in[10], a.in[9], (float)kpos, tid); \
            __syncthreads(); \
            att::attn_wave<5, true>(lds, raw0, g0, (float)qp0, sink2, 2 * (wave & 1), n == 0, Y + qrow * DM + hq * 64, DM, lane); \
            att::attn_wave<5, true>(lds, raw1, g0, (float)qp1, sink2, 2 * (wave & 1) + 1, n == 0, Y + (qrow + 32) * DM + hq * 64, DM, lane); \
            __syncthreads(); } while (0)
#define MEM_UNIT(u_) do { const int u = (u_); const int b = u >> 5, hm = (u >> 3) & 3, qt = u & 7; \
            const long qrow = (long)b * SEQ + qt * 256 + 32 * wave; \
            u32x4 kr[4], vr[4], raw0[4]; \
            att::kv_issue(kr, vr, MKV + (long)b * MEML * 512 + hm * 64, MKV + (long)b * MEML * 512 + 256 + hm * 64, 512, 0, tid); \
            att::q_issue(raw0, PROJ + qrow * INC + 768 + hm * 64, INC, lane); \
            f32x4 g0[2]; g0[0] = (f32x4){1.f, 1.f, 1.f, 1.f}; g0[1] = g0[0]; \
            att::kv_finish<false>(lds, kr, vr, a.in[19], a.in[18], 0.f, tid); \
            __syncthreads(); \
            att::attn_wave<8, false>(lds, raw0, g0, 0.f, 0.f, 0, false, Y + qrow * DM + 768 + hm * 64, DM, lane); \
            __syncthreads(); } while (0)
    if (IN(4)) {
        { pg8::Gemm g{XB, WIN + (size_t)1024 * DM, M, 512, DM, 2 * DM, 128, 128, 32768}; pg8::StaticOrder S; S.init(M, 512, G, bx); pg8::EpiScaleBf16<true> E{PROJ + 1024, INC, ss1};
          pg8::gemm_phase<pg8::EpiScaleBf16<true>, pg8::StaticOrder, true, true>(lds, g, S, E); }
        if (G == 256) {
            if (bx < 128) { MEM_UNIT(128 + bx); }
            else { SWA_UNIT(bx - 128); SWA_UNIT(bx); MEM_UNIT(bx - 128); }
        } else {
#pragma unroll 1
            for (int u = bx; u < 256; u += G) SWA_UNIT(u);
#pragma unroll 1
            for (int u = bx; u < 256; u += G) MEM_UNIT(u);
        }
    }
    SEAM(4);
    if (IN(5)) {
#pragma unroll 1
        for (int u = bx; u < 256; u += G) conv_unit(lds, PROJ, u >> 5, u & 31, a.in[12], a.in[13], a.in[14], a.in[15], Y, tid);
    }
    SEAM(5);
    if (IN(6)) {
        pg8::Gemm g{Y, WOUT, M, DM, DM, 2 * DM, 128, 128, 32768}; pg8::StaticOrder S; S.init(M, DM, G, bx); pg8::EpiResid<1> E{nullptr, nullptr, XB, ss2};
        pg8::gemm_phase<pg8::EpiResid<1>, pg8::StaticOrder, true, true>(lds, g, S, E);
    }
    SEAM(6);
    if (IN(7)) {
        pg8::Gemm g{XB, W2GU, M, 2 * DFF, DM, 2 * DM, 128, 128, 32768}; pg8::StaticOrder S; S.init(M, 2 * DFF, G, bx); pg8::EpiSwiGLU<true> E{ACT, DFF, ss2};
        pg8::gemm_phase<pg8::EpiSwiGLU<true>, pg8::StaticOrder, true, true>(lds, g, S, E);
    }
    SEAM(7);
    if (IN(8)) {
        pg8::Gemm g{ACT, W2D, M, DM, DFF, 128, 32768, 128, 32768}; pg8::StaticOrder S; S.init(M, DM, G, bx); pg8::EpiResid<2> E{nullptr, a.out, XB, nullptr};
        pg8::gemm_phase<pg8::EpiResid<2>, pg8::StaticOrder, true, true>(lds, g, S, E);
    }
#undef IN
#undef SEAM
}

extern "C" void kernel_launch(void* const* d_in, const int* in_sizes, int n_in, void* d_out, int out_size, void* d_ws, size_t ws_size, hipStream_t stream) {
    static int grid = 0;
    if (grid == 0) {
        int dev = 0, cus = 0, per_cu = 0;
        if (n_in != 25 || out_size != M * DM || ws_size < WS_END) { fprintf(stderr, "kernel_launch: unexpected shapes (n_in %d out %d ws %zu)\n", n_in, out_size, ws_size); grid = -1; return; }
        (void)hipGetDevice(&dev); (void)hipDeviceGetAttribute(&cus, hipDeviceAttributeMultiprocessorCount, dev);
        (void)hipFuncSetAttribute((const void*)fwd_kernel, hipFuncAttributeMaxDynamicSharedMemorySize, LDS_BYTES);
        (void)hipOccupancyMaxActiveBlocksPerMultiprocessor(&per_cu, (const void*)fwd_kernel, NTHR, LDS_BYTES);
        if (per_cu < 1) { fprintf(stderr, "kernel_launch: occupancy query says %d blocks per CU\n", per_cu); per_cu = 1; }
        (void)hipGetLastError();
        grid = cus;
    }
    if (grid < 0) return;
    if (hipMemsetAsync((char*)d_ws + WS_CTL, 0, CTL_BYTES, stream) != hipSuccess) { fprintf(stderr, "kernel_launch: memset failed\n"); return; }
    Args a{};
    for (int i = 0; i < 25; ++i) a.in[i] = (const float*)d_in[i];
    a.out = (float*)d_out; a.ws = (unsigned char*)d_ws;
    a.ph_lo = 0; a.ph_hi = NPHASE; a.li = 0;
    {
        void* args[] = {&a};
        hipError_t e = hipLaunchCooperativeKernel((const void*)fwd_kernel, dim3(grid), dim3(NTHR), args, LDS_BYTES, stream);
        if (e != hipSuccess) { fprintf(stderr, "kernel_launch: cooperative launch failed: %s (grid %d)\n", hipGetErrorString(e), grid); }
    }
}
```

```cpp
#include <hip/hip_runtime.h>
#include <hip/hip_cooperative_groups.h>
#include <cstdio>
#include <cstdint>
namespace cg = cooperative_groups;
namespace pg8 {
#define PG8_LAS __attribute__((address_space(3)))
typedef unsigned short bf16_t;
typedef short bf16x8 __attribute__((ext_vector_type(8)));
typedef float f32x4 __attribute__((ext_vector_type(4)));
typedef unsigned u32x4 __attribute__((ext_vector_type(4)));
constexpr int BM = 256, BK = 64, HALF = 128, HTB = HALF * BK * 2  , STAGE_BYTES = 8 * HTB, NXCD = 8, WGM = 8;

__host__ __device__ __forceinline__ int lds_byte(int r, int c) { const int st = (r >> 4) * 2 + (c >> 5), rr = r & 15, cc = c & 31, ob = rr * 64 + cc * 2; return st * 1024 + (ob ^ (((ob >> 9) & 1) << 5)); }
__host__ __device__ __forceinline__ void stage_rc(int b, int& R, int& C) { const int st = b / 1024, sb = b % 1024, swz = sb ^ (((sb >> 9) & 1) << 5); R = (st >> 1) * 16 + swz / 64; C = (st & 1) * 32 + (swz % 64) / 2; }
__host__ __device__ __forceinline__ int perm32(int rho) { const int n = rho >> 4, i = rho & 15; return 8 * (i >> 2) + 4 * n + (i & 3); }

struct Unit { int pm, pn; };
struct Gemm { const bf16_t* A; const bf16_t* Bt; int M, N, K; int apitch, akstep, bpitch, bkstep; };

struct StaticOrder {
    int nM, nN, nwg, G, c;
    __host__ __device__ void init(int M, int N, int G_, int c_) { nM = M / BM; nN = N / BM; nwg = nM * nN; G = G_; c = c_; }
    __host__ __device__ bool next(int i, Unit& u) const {
        const long L = (long)i * G + c; if (L >= nwg) return false;
        int wgid = (int)L; { const int q = nwg / NXCD, r = nwg % NXCD, xcd = wgid % NXCD, off = wgid / NXCD; wgid = (xcd < r ? xcd * (q + 1) : r * (q + 1) + (xcd - r) * q) + off; }
        const int nig = WGM * nN, gid = wgid / nig, fm = gid * WGM, gsz = (nM - fm) < WGM ? (nM - fm) : WGM;
        u.pm = fm + ((wgid % nig) % gsz); u.pn = (wgid % nig) / gsz; return true;
    }
    __device__ __forceinline__ void a_ready(const Unit&) const {}
    __device__ __forceinline__ void done(const Unit&) const {}
};

__device__ __forceinline__ unsigned cvt_pk_bf16(float lo, float hi) { unsigned r; asm volatile("v_cvt_pk_bf16_f32 %0, %1, %2" : "=v"(r) : "v"(lo), "v"(hi)); return r; }
__device__ __forceinline__ void st16_wt(const void* base, unsigned off, u32x4 v) {
    __amdgpu_buffer_rsrc_t r = __builtin_amdgcn_make_buffer_rsrc(const_cast<void*>(base), 0, 0x7fffffff, 0x00020000);
    __builtin_amdgcn_raw_buffer_store_b128(v, r, (int)off, 0, 16);
}
__device__ __forceinline__ void st16_wt(const void* base, unsigned off, f32x4 v) { st16_wt(base, off, __builtin_bit_cast(u32x4, v)); }
typedef float f32x2 __attribute__((ext_vector_type(2)));
template <class Epi, class Sched, bool ALIGN_EPI = false, bool SP2 = false>
__device__ __forceinline__ void gemm_phase(PG8_LAS unsigned char* lds, const Gemm g, const Sched& S, const Epi& E) {
    const int tid = threadIdx.x, wid = __builtin_amdgcn_readfirstlane(tid >> 6), lane = tid & 63, wr = wid >> 2, wc = wid & 3, fr = lane & 15, fq = lane >> 4;
    const int K = g.K, nt = K / BK;
    unsigned voffA[2], voffB[2];
#pragma unroll
    for (int i = 0; i < 2; ++i) { int R, C; stage_rc(tid * 16 + i * 8192, R, C); const int Rb = Epi::PERM ? ((R & ~31) + perm32(R & 31)) : R;
        voffA[i] = (unsigned)(R * g.apitch + C * 2); voffB[i] = (unsigned)(Rb * g.bpitch + C * 2); }
    const size_t kstepA = (size_t)g.akstep, kstepB = (size_t)g.bkstep;
    const size_t hstepA = (size_t)HALF * g.apitch, hstepB = (size_t)HALF * g.bpitch;
    const size_t tstep = (size_t)BM * K * 2;
    const unsigned ldsw = (unsigned)wid * 1024u;
    const int aoff = lds_byte(wr * 64 + fr, fq * 8), boff = lds_byte(wc * 32 + fr, fq * 8);
#define PG8_SA(b, h) (((b) * 2 + (h)) * HTB)
#define PG8_SB(b, h) ((4 + (b) * 2 + (h)) * HTB)
#define PG8_STAGE(bufoff, gbase, voff) do { _Pragma("unroll") for (int _i = 0; _i < 2; ++_i) \
        __builtin_amdgcn_global_load_lds((const unsigned*)((const char*)(gbase) + (voff)[_i]), (PG8_LAS unsigned*)(lds + (bufoff) + ldsw + _i * 8192), 16, 0, 0); } while (0)
#define PG8_LDA(dst, b, h) do { _Pragma("unroll") for (int m = 0; m < 4; ++m) _Pragma("unroll") for (int k = 0; k < 2; ++k) dst[m][k] = *(const PG8_LAS bf16x8*)(lds + PG8_SA(b, h) + aoff + m * 2048 + k * 1024); } while (0)
#define PG8_LDB(dst, b, h) do { _Pragma("unroll") for (int n = 0; n < 2; ++n) _Pragma("unroll") for (int k = 0; k < 2; ++k) dst[n][k] = *(const PG8_LAS bf16x8*)(lds + PG8_SB(b, h) + boff + n * 2048 + k * 1024); } while (0)
#define PG8_MMA(ai, bj, At, Bt) do { __builtin_amdgcn_s_setprio(1); _Pragma("unroll") for (int m = 0; m < 4; ++m) _Pragma("unroll") for (int n = 0; n < 2; ++n) _Pragma("unroll") for (int k = 0; k < 2; ++k) \
        acc[ai][bj][m][n] = __builtin_amdgcn_mfma_f32_16x16x32_bf16(Bt[n][k], At[m][k], acc[ai][bj][m][n], 0, 0, 0); __builtin_amdgcn_s_setprio(0); } while (0)
#define PG8_WAIT_V(n) asm volatile("s_waitcnt vmcnt(" #n ")" ::: "memory")
#define PG8_WAIT_L(n) asm volatile("s_waitcnt lgkmcnt(" #n ")" ::: "memory")
#define PG8_BAR __builtin_amdgcn_s_barrier()
#define PG8_SCHED __builtin_amdgcn_sched_barrier(0)
    Unit cur, nxt; int ui = 0;
    if (!S.next(0, cur)) return;
    float epre[8]; E.prefetch(epre, cur, wr, fr);
    f32x4 acc[2][2][4][2];
#pragma unroll
    for (int a = 0; a < 2; ++a)
#pragma unroll
        for (int b = 0; b < 2; ++b)
#pragma unroll
            for (int m = 0; m < 4; ++m)
#pragma unroll
                for (int n = 0; n < 2; ++n) acc[a][b][m][n] = (f32x4){0.f, 0.f, 0.f, 0.f};
    bf16x8 At[4][2], B0[2][2], B1[2][2];
    const char* cA = (const char*)g.A + (size_t)cur.pm * tstep; const char* cB = (const char*)g.Bt + (size_t)cur.pn * tstep;
    S.a_ready(cur);
    if constexpr (SP2) {
        PG8_STAGE(PG8_SB(0, 0), cB, voffB); PG8_STAGE(PG8_SB(0, 1), cB + hstepB, voffB); PG8_STAGE(PG8_SA(0, 0), cA, voffA); PG8_STAGE(PG8_SA(0, 1), cA + hstepA, voffA);
        if (wr == 1) PG8_BAR;
        PG8_WAIT_V(2); PG8_BAR;
        PG8_STAGE(PG8_SB(1, 0), cB + kstepB, voffB); PG8_STAGE(PG8_SA(1, 0), cA + kstepA, voffA); PG8_STAGE(PG8_SB(1, 1), cB + hstepB + kstepB, voffB);
        PG8_WAIT_V(6); PG8_BAR;
    } else {
        PG8_STAGE(PG8_SB(0, 0), cB, voffB); PG8_STAGE(PG8_SA(0, 0), cA, voffA); PG8_STAGE(PG8_SB(0, 1), cB + hstepB, voffB); PG8_STAGE(PG8_SA(0, 1), cA + hstepA, voffA);
        if (wr == 1) PG8_BAR;
        PG8_WAIT_V(4); PG8_BAR;
        PG8_STAGE(PG8_SB(1, 0), cB + kstepB, voffB); PG8_STAGE(PG8_SA(1, 0), cA + kstepA, voffA); PG8_STAGE(PG8_SB(1, 1), cB + hstepB + kstepB, voffB);
        PG8_WAIT_V(6); PG8_BAR;
    }
    for (;;) {
        const bool has_next = S.next(ui + 1, nxt);
        const char* nA = has_next ? (const char*)g.A + (size_t)nxt.pm * tstep : cA; const char* nB = has_next ? (const char*)g.Bt + (size_t)nxt.pn * tstep : cB;
        for (int t = 0; t < nt; t += 2) {
            const bool last = (t == nt - 2);
            const char* a1 = cA + (size_t)(t + 1) * kstepA;
            const char* a2 = last ? nA : cA + (size_t)(t + 2) * kstepA; const char* b2 = last ? nB : cB + (size_t)(t + 2) * kstepB;
            const char* a3 = a2 + kstepA; const char* b3 = b2 + kstepB;
            if (last && has_next) S.a_ready(nxt);
            if constexpr (SP2) {
            PG8_LDB(B0, 0, 0); PG8_LDB(B1, 0, 1); PG8_SCHED; PG8_LDA(At, 0, 0); PG8_STAGE(PG8_SA(1, 1), a1 + hstepA, voffA);
            PG8_WAIT_V(8); PG8_WAIT_L(0); PG8_BAR; PG8_MMA(0, 0, At, B0); PG8_MMA(0, 1, At, B1); PG8_BAR; PG8_SCHED;
            PG8_LDA(At, 0, 1); PG8_STAGE(PG8_SB(0, 0), b2, voffB); PG8_STAGE(PG8_SB(0, 1), b2 + hstepB, voffB); PG8_STAGE(PG8_SA(0, 0), a2, voffA);
            PG8_WAIT_V(8); PG8_WAIT_L(0); PG8_BAR; PG8_MMA(1, 0, At, B0); PG8_MMA(1, 1, At, B1); PG8_BAR; PG8_SCHED;
            PG8_LDB(B0, 1, 0); PG8_LDB(B1, 1, 1); PG8_SCHED; PG8_LDA(At, 1, 0); PG8_STAGE(PG8_SA(0, 1), a2 + hstepA, voffA);
            PG8_WAIT_V(8); PG8_WAIT_L(0); PG8_BAR; PG8_MMA(0, 0, At, B0); PG8_MMA(0, 1, At, B1); PG8_BAR; PG8_SCHED;
            PG8_LDA(At, 1, 1); PG8_STAGE(PG8_SB(1, 0), b3, voffB); PG8_STAGE(PG8_SB(1, 1), b3 + hstepB, voffB); PG8_STAGE(PG8_SA(1, 0), a3, voffA);
            PG8_WAIT_V(8); PG8_WAIT_L(0); PG8_BAR; PG8_MMA(1, 0, At, B0); PG8_MMA(1, 1, At, B1); PG8_BAR; PG8_SCHED;
            } else {
            PG8_LDB(B0, 0, 0); PG8_SCHED; PG8_LDA(At, 0, 0); PG8_STAGE(PG8_SA(1, 1), a1 + hstepA, voffA);
            PG8_WAIT_L(8); PG8_BAR; PG8_WAIT_L(0); PG8_MMA(0, 0, At, B0); PG8_BAR; PG8_SCHED;
            PG8_LDB(B1, 0, 1); PG8_STAGE(PG8_SB(0, 0), b2, voffB);
            PG8_BAR; PG8_WAIT_L(0); PG8_MMA(0, 1, At, B1); PG8_BAR;
            PG8_LDA(At, 0, 1); PG8_STAGE(PG8_SA(0, 0), a2, voffA);
            PG8_BAR; PG8_WAIT_L(0); PG8_MMA(1, 0, At, B0); PG8_BAR; PG8_SCHED;
            PG8_STAGE(PG8_SB(0, 1), b2 + hstepB, voffB);
            PG8_WAIT_V(6); PG8_BAR; PG8_MMA(1, 1, At, B1); PG8_BAR;
            PG8_LDB(B0, 1, 0); PG8_SCHED; PG8_LDA(At, 1, 0); PG8_STAGE(PG8_SA(0, 1), a2 + hstepA, voffA);
            PG8_WAIT_L(8); PG8_BAR; PG8_WAIT_L(0); PG8_MMA(0, 0, At, B0); PG8_BAR; PG8_SCHED;
            PG8_LDB(B1, 1, 1); PG8_STAGE(PG8_SB(1, 0), b3, voffB);
            PG8_BAR; PG8_WAIT_L(0); PG8_MMA(0, 1, At, B1); PG8_BAR;
            PG8_LDA(At, 1, 1); PG8_STAGE(PG8_SA(1, 0), a3, voffA);
            PG8_BAR; PG8_WAIT_L(0); PG8_MMA(1, 0, At, B0); PG8_BAR; PG8_SCHED;
            PG8_STAGE(PG8_SB(1, 1), b3 + hstepB, voffB);
            PG8_WAIT_V(6); PG8_BAR; PG8_MMA(1, 1, At, B1); PG8_BAR;
            }
        }
        if constexpr (ALIGN_EPI) { if (wr == 0) PG8_BAR; }
        if constexpr (!Epi::AFTER_DRAIN) { E(acc, cur, wr, wc, fr, fq, epre); S.done(cur); if (has_next) E.prefetch(epre, nxt, wr, fr); }
        if (!has_next) break;
#pragma unroll
        for (int a = 0; a < 2; ++a)
#pragma unroll
            for (int b = 0; b < 2; ++b)
#pragma unroll
                for (int m = 0; m < 4; ++m)
#pragma unroll
                    for (int n = 0; n < 2; ++n) acc[a][b][m][n] = (f32x4){0.f, 0.f, 0.f, 0.f};
        cur = nxt; cA = nA; cB = nB; ++ui;
        if constexpr (ALIGN_EPI) { if (wr == 1) PG8_BAR; }
    }
    PG8_WAIT_V(0);
    if constexpr (!ALIGN_EPI) { if (wr == 0) PG8_BAR; }
    PG8_BAR;
    if constexpr (Epi::AFTER_DRAIN) { E.fused(acc, cur, wr, wc, fr, fq, lds, wid, lane); S.done(cur); }
#undef PG8_SA
#undef PG8_SB
#undef PG8_STAGE
#undef PG8_LDA
#undef PG8_LDB
#undef PG8_MMA
#undef PG8_WAIT_V
#undef PG8_WAIT_L
#undef PG8_BAR
#undef PG8_SCHED
}
}
namespace pg8 {
__device__ __forceinline__ float rstd_of(float ss) { return __builtin_amdgcn_rsqf(ss * (1.0f / 1024.0f) + 1e-6f); }
__device__ __forceinline__ float silu_mul(float g, float u) { return g * __builtin_amdgcn_rcpf(1.0f + __builtin_amdgcn_exp2f(-1.4426950408889634f * g)) * u; }
template <bool SS> struct EpiSwiGLU {
    static constexpr bool PERM = true, AFTER_DRAIN = false;
    bf16_t* O; int ldc; const float* ss;
    __device__ __forceinline__ void prefetch(float (&pre)[8], const Unit& u, int wr, int fr) const {
        const int row0 = u.pm * BM + wr * 64 + fr;
#pragma unroll
        for (int i = 0; i < 8; ++i) pre[i] = SS ? ss[row0 + (i >> 2) * HALF + (i & 3) * 16] : 1.f;
    }
    __device__ __forceinline__ void operator()(const f32x4 (&acc)[2][2][4][2], const Unit& u, int wr, int wc, int fr, int fq, const float (&pre)[8]) const {
        const int row0 = u.pm * BM + wr * 64 + fr, col0 = u.pn * HALF + wc * 32 + 8 * fq;
        float rsv[8];
#pragma unroll
        for (int i = 0; i < 8; ++i) rsv[i] = pre[i];
        if (SS) {
#pragma unroll
            for (int i = 0; i < 8; ++i) rsv[i] = rstd_of(rsv[i]); }
#pragma unroll
        for (int ai = 0; ai < 2; ++ai)
#pragma unroll
            for (int m = 0; m < 4; ++m) {
                const int row = row0 + ai * HALF + m * 16; const float rs = rsv[ai * 4 + m];
                typedef float f32x2 __attribute__((ext_vector_type(2)));
                u32x4 w;
#pragma unroll
                for (int n = 0; n < 2; ++n) {
                    const f32x4 gq = acc[ai][0][m][n], uq = acc[ai][1][m][n];
#pragma unroll
                    for (int hh = 0; hh < 2; ++hh) {
                        f32x2 g = (f32x2){gq[2 * hh], gq[2 * hh + 1]}, uu = (f32x2){uq[2 * hh], uq[2 * hh + 1]};
                        if (SS) { g = g * rs; uu = uu * rs; }
                        const f32x2 t = g * (-1.4426950408889634f);
                        f32x2 e; e.x = __builtin_amdgcn_exp2f(t.x); e.y = __builtin_amdgcn_exp2f(t.y);
                        const f32x2 d = e + 1.0f;
                        f32x2 r; r.x = __builtin_amdgcn_rcpf(d.x); r.y = __builtin_amdgcn_rcpf(d.y);
                        const f32x2 o = (g * uu) * r;
                        w[2 * n + hh] = cvt_pk_bf16(o.x, o.y);
                    }
                }
                st16_wt(O, (unsigned)((((size_t)u.pm * (ldc >> 6) + (col0 >> 6)) * 256 + (row & 255)) * 64 + (col0 & 63)) * 2u, w);
            }
    }
};
template <bool SS> struct EpiScaleBf16 {
    static constexpr bool PERM = true, AFTER_DRAIN = false;
    bf16_t* O; int ldc; const float* ss;
    __device__ __forceinline__ void prefetch(float (&pre)[8], const Unit& u, int wr, int fr) const {
        const int row0 = u.pm * BM + wr * 64 + fr;
#pragma unroll
        for (int i = 0; i < 8; ++i) pre[i] = SS ? ss[row0 + (i >> 2) * HALF + (i & 3) * 16] : 1.f;
    }
    __device__ __forceinline__ void operator()(const f32x4 (&acc)[2][2][4][2], const Unit& u, int wr, int wc, int fr, int fq, const float (&pre)[8]) const {
        const int row0 = u.pm * BM + wr * 64 + fr, col0 = u.pn * BM + wc * 32 + 8 * fq;
        float rsv[8];
#pragma unroll
        for (int i = 0; i < 8; ++i) rsv[i] = pre[i];
        if (SS) {
#pragma unroll
            for (int i = 0; i < 8; ++i) rsv[i] = rstd_of(rsv[i]); }
#pragma unroll
        for (int ai = 0; ai < 2; ++ai)
#pragma unroll
            for (int m = 0; m < 4; ++m) {
                const int row = row0 + ai * HALF + m * 16; const float rs = rsv[ai * 4 + m];
#pragma unroll
                for (int bj = 0; bj < 2; ++bj) {
                    const f32x4 v0 = acc[ai][bj][m][0] * rs, v1 = acc[ai][bj][m][1] * rs; u32x4 w;
                    w.x = cvt_pk_bf16(v0[0], v0[1]); w.y = cvt_pk_bf16(v0[2], v0[3]); w.z = cvt_pk_bf16(v1[0], v1[1]); w.w = cvt_pk_bf16(v1[2], v1[3]);
                    st16_wt(O, (unsigned)((size_t)row * ldc + col0 + bj * HALF) * 2u, w);
                }
            }
    }
};
template <int MODE> struct EpiResid {
    static constexpr bool PERM = true, AFTER_DRAIN = false;
    const float* base; float* out; bf16_t* xb; float* ssn;
    __device__ __forceinline__ void prefetch(float (&)[8], const Unit&, int, int) const {}
    __device__ __forceinline__ void operator()(const f32x4 (&acc)[2][2][4][2], const Unit& u, int wr, int wc, int fr, int fq, const float (&)[8]) const {
        const int row0 = u.pm * BM + wr * 64 + fr, col0 = u.pn * BM + wc * 32 + 8 * fq;
        f32x4 pre[2][2][2]; u32x4 preb[2][2];
#define EPR_LOAD(slot, it) do { const size_t off_ = (size_t)(row0 + ((it) >> 2) * HALF + ((it) & 3) * 16) * 1024 + col0; \
        if (MODE == 0) { pre[slot][0][0] = __builtin_nontemporal_load((const f32x4*)(base + off_)); pre[slot][0][1] = __builtin_nontemporal_load((const f32x4*)(base + off_ + 4)); pre[slot][1][0] = __builtin_nontemporal_load((const f32x4*)(base + off_ + HALF)); pre[slot][1][1] = __builtin_nontemporal_load((const f32x4*)(base + off_ + HALF + 4)); } \
        else { preb[slot][0] = *(const u32x4*)(xb + off_); preb[slot][1] = *(const u32x4*)(xb + off_ + HALF); } } while (0)
        EPR_LOAD(0, 0); EPR_LOAD(1, 1);
        float sacc[8];
#pragma unroll
        for (int it = 0; it < 8; ++it) {
            const int ai = it >> 2, m = it & 3, row = row0 + ai * HALF + m * 16; float s = 0.f;
            f32x4 v[2][2];
#pragma unroll
            for (int bj = 0; bj < 2; ++bj) {
                f32x4 b0, b1;
                if (MODE == 0) { b0 = pre[it & 1][bj][0]; b1 = pre[it & 1][bj][1]; }
                else { const u32x4 w = preb[it & 1][bj]; b0 = (f32x4){__uint_as_float(w.x << 16), __uint_as_float(w.x & 0xffff0000u), __uint_as_float(w.y << 16), __uint_as_float(w.y & 0xffff0000u)};
                       b1 = (f32x4){__uint_as_float(w.z << 16), __uint_as_float(w.z & 0xffff0000u), __uint_as_float(w.w << 16), __uint_as_float(w.w & 0xffff0000u)}; }
                v[bj][0] = b0 + acc[ai][bj][m][0]; v[bj][1] = b1 + acc[ai][bj][m][1]; }
            if (it + 2 < 8) EPR_LOAD(it & 1, it + 2);
#pragma unroll
            for (int bj = 0; bj < 2; ++bj) {
                const size_t off = (size_t)row * 1024 + col0 + bj * HALF; const f32x4 v0 = v[bj][0], v1 = v[bj][1];
                if (MODE == 2) { *(f32x4*)(out + off) = v0; *(f32x4*)(out + off + 4) = v1; }
                else {
                    s += (v0[0] * v0[0] + v0[1] * v0[1]) + (v0[2] * v0[2] + v0[3] * v0[3]) + (v1[0] * v1[0] + v1[1] * v1[1]) + (v1[2] * v1[2] + v1[3] * v1[3]);
                    u32x4 w; w.x = cvt_pk_bf16(v0[0], v0[1]); w.y = cvt_pk_bf16(v0[2], v0[3]); w.z = cvt_pk_bf16(v1[0], v1[1]); w.w = cvt_pk_bf16(v1[2], v1[3]);
                    st16_wt(xb, (unsigned)off * 2u, w);
                }
            }
            sacc[it] = s;
        }
#undef EPR_LOAD
        if (MODE != 2) {
#pragma unroll
            for (int it = 0; it < 8; ++it) { float s = sacc[it]; s += __shfl_xor(s, 16); s += __shfl_xor(s, 32); if (fq == 0) unsafeAtomicAdd(ssn + row0 + (it >> 2) * HALF + (it & 3) * 16, s); }
        }
    }
};
struct ExtraOrder {
    int c, c0, nN, n;
    __device__ bool next(int i, Unit& u) const { const int k = c - c0; if (i > 0 || k < 0 || k >= n) return false; u.pm = k / nN; u.pn = k % nN; return true; }
    __device__ __forceinline__ void a_ready(const Unit&) const {}
    __device__ __forceinline__ void done(const Unit&) const {}
};
}

constexpr int BATCH = 8, SEQ = 2048, DM = 1024, M = BATCH * SEQ, DFF = 2816, INC = 1536, MEML = 256, MROWS = BATCH * MEML;
constexpr int NWAVES = 8, NTHR = 512;
#define LAS __attribute__((address_space(3)))
typedef unsigned short bf16;
typedef unsigned u32x4 __attribute__((ext_vector_type(4)));
typedef unsigned u32x2 __attribute__((ext_vector_type(2)));
typedef float f32x4 __attribute__((ext_vector_type(4)));
typedef float f32x16 __attribute__((ext_vector_type(16)));
typedef short bf16x8 __attribute__((ext_vector_type(8)));
typedef short s16x4 __attribute__((ext_vector_type(4)));
constexpr size_t MiB = 1u << 20;
constexpr size_t WS_CTL = 512 * 1024, CTL_BYTES = 64 * 1024;
constexpr size_t WS_SS0 = 0, WS_SS1 = 64 * 1024, WS_SS2 = 128 * 1024, WS_SSM = 192 * 1024;
constexpr size_t WS_W1GU = 1 * MiB, WS_W1D = 12 * MiB, WS_W2GU = 18 * MiB, WS_W2D = 29 * MiB, WS_WIN = 35 * MiB, WS_WOUT = 38 * MiB, WS_WMKV = 40 * MiB;
constexpr size_t WS_XB = 41 * MiB, WS_ACT = 73 * MiB, WS_PROJ = 73 * MiB, WS_Y = 121 * MiB, WS_MEMB = 161 * MiB, WS_MKV = 165 * MiB, WS_END = 167 * MiB;
static_assert(WS_W1GU + (size_t)2 * DFF * DM * 2 <= WS_W1D && WS_W1D + (size_t)DM * DFF * 2 <= WS_W2GU && WS_W2GU + (size_t)2 * DFF * DM * 2 <= WS_W2D && WS_W2D + (size_t)DM * DFF * 2 <= WS_WIN, "ws map");
static_assert(WS_WIN + (size_t)INC * DM * 2 <= WS_WOUT && WS_WOUT + (size_t)DM * DM * 2 <= WS_WMKV && WS_WMKV + (size_t)512 * DM * 2 <= WS_XB, "ws map");
static_assert(WS_ACT + (size_t)M * DFF * 2 <= WS_MEMB && WS_PROJ + (size_t)M * INC * 2 <= WS_Y && WS_Y + (size_t)M * DM * 2 <= WS_MEMB, "ws map");
constexpr int LDS_BYTES = 147456, RING_BYTES = 131072;

typedef float f32x2_t __attribute__((ext_vector_type(2))); typedef __bf16 bf16x2_t __attribute__((ext_vector_type(2)));
__device__ __forceinline__ unsigned pk2(float lo, float hi) { f32x2_t v = {lo, hi}; bf16x2_t b = __builtin_convertvector(v, bf16x2_t); return __builtin_bit_cast(unsigned, b); }
__device__ __forceinline__ float bflo(unsigned w) { return __uint_as_float(w << 16); }
__device__ __forceinline__ float bfhi(unsigned w) { return __uint_as_float(w & 0xffff0000u); }
__device__ __forceinline__ float wave_sum(float v) {
    v += __builtin_bit_cast(float, __builtin_amdgcn_update_dpp(0, __builtin_bit_cast(int, v), 0xB1, 0xf, 0xf, true));
    v += __builtin_bit_cast(float, __builtin_amdgcn_update_dpp(0, __builtin_bit_cast(int, v), 0x4E, 0xf, 0xf, true));
    v += __builtin_bit_cast(float, __builtin_amdgcn_update_dpp(0, __builtin_bit_cast(int, v), 0x141, 0xf, 0xf, true));
    v += __builtin_bit_cast(float, __builtin_amdgcn_update_dpp(0, __builtin_bit_cast(int, v), 0x140, 0xf, 0xf, true));
    v += __builtin_bit_cast(float, __builtin_amdgcn_update_dpp(0, __builtin_bit_cast(int, v), 0x142, 0xa, 0xf, true));
    v += __builtin_bit_cast(float, __builtin_amdgcn_update_dpp(0, __builtin_bit_cast(int, v), 0x143, 0xc, 0xf, true));
    return __builtin_bit_cast(float, __builtin_amdgcn_readlane(__builtin_bit_cast(int, v), 63));
}
__device__ __forceinline__ void transpose_item(const float* W, int K, int N, bf16* WT, int mode, const float* g, float scale, LAS float* scr, int item, int lane) {
    const int nblk = N / 64, kb = item / nblk, nb = item % nblk, k0 = 64 * kb, n0 = 64 * nb;
    const int kr = lane >> 4, n4 = (lane & 15) * 4;
    f32x4 v[16];
#pragma unroll
    for (int i = 0; i < 16; ++i) v[i] = __builtin_nontemporal_load((const f32x4*)(W + (size_t)(k0 + kr + 4 * i) * N + n0 + n4));
#pragma unroll
    for (int i = 0; i < 16; ++i) { const float gv = g ? g[k0 + kr + 4 * i] * scale : scale; LAS float* d = scr + (kr + 4 * i) * 65 + n4;
        d[0] = v[i].x * gv; d[1] = v[i].y * gv; d[2] = v[i].z * gv; d[3] = v[i].w * gv; }
    asm volatile("s_waitcnt lgkmcnt(0)" ::: "memory");
    const int rb = mode == 0 ? n0 : mode == 3 ? (n0 < 768 ? n0 : n0 < 1280 ? n0 + 256 : n0 - 512) : (256 * (n0 >> 7) + (n0 & 127) + (mode == 2 ? 128 : 0));
    const int c = lane & 7;
#pragma unroll
    for (int j = 0; j < 8; ++j) { const int n = (lane >> 3) + 8 * j; const LAS float* s = scr + (8 * c) * 65 + n;
        u32x4 o; o.x = pk2(s[0 * 65], s[1 * 65]); o.y = pk2(s[2 * 65], s[3 * 65]); o.z = pk2(s[4 * 65], s[5 * 65]); o.w = pk2(s[6 * 65], s[7 * 65]);
        const int row = rb + n; *(u32x4*)(WT + (((size_t)(row >> 8) * (K >> 6) + (k0 >> 6)) * 256 + (row & 255)) * 64 + 8 * c) = o; }
    asm volatile("s_waitcnt lgkmcnt(0)" ::: "memory");
}
__device__ __forceinline__ void rows4_to_bf16_norm(const float* xrow, bf16* orow, int lane) {
    f32x4 v[4][4];
#pragma unroll
    for (int r = 0; r < 4; ++r)
#pragma unroll
        for (int j = 0; j < 4; ++j) v[r][j] = __builtin_nontemporal_load((const f32x4*)(xrow + (size_t)r * DM) + 64 * j + lane);
#pragma unroll
    for (int r = 0; r < 4; ++r) { float s = 0.f;
#pragma unroll
        for (int j = 0; j < 4; ++j) s += (v[r][j].x * v[r][j].x + v[r][j].y * v[r][j].y) + (v[r][j].z * v[r][j].z + v[r][j].w * v[r][j].w);
        const float rs = __builtin_amdgcn_rsqf(wave_sum(s) * (1.0f / 1024.0f) + 1e-6f);
        u32x2* o8 = (u32x2*)(orow + (size_t)r * DM) + lane;
#pragma unroll
        for (int j = 0; j < 4; ++j) { u32x2 w; w.x = pk2(v[r][j].x * rs, v[r][j].y * rs); w.y = pk2(v[r][j].z * rs, v[r][j].w * rs); o8[64 * j] = w; } }
}
namespace att {
constexpr int ROWB = 144, KOFF = 0, VOFF = 256 * ROWB;
constexpr float LOG2E = 1.4426950408889634f;
__device__ __forceinline__ int crow(int r, int h) { return (r & 3) + 8 * (r >> 2) + 4 * h; }
__device__ __forceinline__ void sincos_rev(float ang, float& s, float& c) {
    const float hi = ang * 0.15915493667125702f, lo = __builtin_fmaf(ang, 0.15915493667125702f, -hi) + ang * 6.4206382432985265e-09f;
    const float r = __builtin_amdgcn_fractf(hi) + lo; s = __builtin_amdgcn_sinf(r); c = __builtin_amdgcn_cosf(r);
}
__device__ __forceinline__ float inv_freq(int i) {
    return i == 0 ? 1.0f : i == 1 ? 0.19392274474868576f : i == 2 ? 0.03760603093086393f : i == 3 ? 0.007292664737217109f : i == 4 ? 0.001414213562373095f : i == 5 ? 0.0002742481756762073f : i == 6 ? 5.318295896944988e-05f : 1.031338537721246e-05f;
}
__device__ __forceinline__ void kv_issue(u32x4 (&kr)[4], u32x4 (&vr)[4], const bf16* Ksrc, const bf16* Vsrc, int ld, int row_lo, int tid) {
    const int key = tid >> 1, half = tid & 1;
#pragma unroll
    for (int c = 0; c < 4; ++c) { kr[c] = (u32x4){0u, 0u, 0u, 0u}; vr[c] = (u32x4){0u, 0u, 0u, 0u}; }
    if (key >= row_lo) {
        const u32x4* kp = (const u32x4*)(Ksrc + (long)key * ld + 32 * half); const u32x4* vp = (const u32x4*)(Vsrc + (long)key * ld + 32 * half);
#pragma unroll
        for (int c = 0; c < 4; ++c) { kr[c] = kp[c]; vr[c] = vp[c]; }
    }
}
template <bool ROPE> __device__ __forceinline__ void kv_finish(LAS unsigned char* lds, const u32x4 (&kr)[4], const u32x4 (&vr)[4], const float* gk, const float* gq, float p, int tid) {
    const int key = tid >> 1, half = tid & 1;
    f32x4 gkv[8], gqv[8];
#pragma unroll
    for (int c = 0; c < 8; ++c) { gkv[c] = *(const f32x4*)(gk + 32 * half + 4 * c); gqv[c] = *(const f32x4*)(gq + 32 * half + 4 * c); }
    LAS unsigned char* vdst = lds + VOFF + key * ROWB + 64 * half;
#pragma unroll
    for (int c = 0; c < 4; ++c) *(LAS u32x4*)(vdst + 16 * c) = vr[c];
    float f[32]; float ss = 0.f;
#pragma unroll
    for (int c = 0; c < 4; ++c)
#pragma unroll
        for (int w = 0; w < 4; ++w) { const unsigned x = kr[c][w]; f[8 * c + 2 * w] = bflo(x); f[8 * c + 2 * w + 1] = bfhi(x); }
#pragma unroll
    for (int i = 0; i < 32; ++i) ss += f[i] * f[i];
    ss += __shfl_xor(ss, 1);
    const float rs = __builtin_amdgcn_rsqf(ss * (1.0f / 64.0f) + 1e-6f);
#pragma unroll
    for (int i = 0; i < 32; ++i) { const float gkk = gkv[i >> 2][i & 3], gqq = gqv[i >> 2][i & 3]; f[i] *= rs * ((ROPE && i < 16) ? (half == 0 ? gkk : gkk * gqq) : gkk * gqq); }
    if (ROPE) {
        if (half == 0) {
#pragma unroll
            for (int i = 0; i < 8; ++i) { float s, c; sincos_rev(p * inv_freq(i), s, c); const float x1 = f[i], x2 = f[8 + i]; f[i] = x1 * c - x2 * s; f[8 + i] = x2 * c + x1 * s; }
        }
    }
    LAS unsigned char* kdst = lds + KOFF + key * ROWB + 64 * half;
#pragma unroll
    for (int c = 0; c < 4; ++c) { u32x4 w; w.x = pk2(f[8 * c], f[8 * c + 1]); w.y = pk2(f[8 * c + 2], f[8 * c + 3]); w.z = pk2(f[8 * c + 4], f[8 * c + 5]); w.w = pk2(f[8 * c + 6], f[8 * c + 7]); *(LAS u32x4*)(kdst + 16 * c) = w; }
}
__device__ __forceinline__ void q_issue(u32x4 (&raw)[4], const bf16* Qrow0, int ldq, int lane) {
    const int ql = lane & 31, h = lane >> 5;
#pragma unroll
    for (int ds = 0; ds < 4; ++ds) raw[ds] = *(const u32x4*)(Qrow0 + (long)ql * ldq + 16 * ds + 8 * h);
}
template <int NKT, bool SWA> __device__ __forceinline__ void attn_wave(LAS unsigned char* lds, const u32x4 (&raw)[4], const f32x4 (&g0)[2], float p_, float sink2, int t0, bool blk0, bf16* Orow0, int ldo, int lane) {
    const int ql = lane & 31, h = lane >> 5;
    float f[4][8]; float ss = 0.f;
#pragma unroll
    for (int ds = 0; ds < 4; ++ds)
#pragma unroll
        for (int w = 0; w < 4; ++w) { const unsigned x = raw[ds][w]; f[ds][2 * w] = bflo(x); f[ds][2 * w + 1] = bfhi(x); }
#pragma unroll
    for (int ds = 0; ds < 4; ++ds)
#pragma unroll
        for (int i = 0; i < 8; ++i) ss += f[ds][i] * f[ds][i];
    ss += __shfl_xor(ss, 32);
    const float rs = __builtin_amdgcn_rsqf(ss * (1.0f / 64.0f) + 1e-6f) * (0.125f * LOG2E);
#pragma unroll
    for (int ds = 0; ds < 4; ++ds)
#pragma unroll
        for (int i = 0; i < 8; ++i) f[ds][i] *= rs;
    if (SWA) {
#pragma unroll
        for (int i = 0; i < 8; ++i) f[0][i] *= g0[i >> 2][i & 3];
#pragma unroll
        for (int i = 0; i < 8; ++i) { float s, c; sincos_rev(p_ * inv_freq(i), s, c); const float other = __shfl_xor(f[0][i], 32); f[0][i] = f[0][i] * c + (h ? other : -other) * s; }
    }
    bf16x8 qf[4];
#pragma unroll
    for (int ds = 0; ds < 4; ++ds) { u32x4 w; w.x = pk2(f[ds][0], f[ds][1]); w.y = pk2(f[ds][2], f[ds][3]); w.z = pk2(f[ds][4], f[ds][5]); w.w = pk2(f[ds][6], f[ds][7]); qf[ds] = __builtin_bit_cast(bf16x8, w); }
    constexpr float SOFF = 8.0f;
    f32x16 p[NKT];
#pragma unroll
    for (int kt = 0; kt < NKT; ++kt) {
#pragma unroll
        for (int r = 0; r < 16; ++r) p[kt][r] = -SOFF;
        const LAS unsigned char* kb = lds + KOFF + (32 * (t0 + kt) + ql) * ROWB + 16 * h;
#pragma unroll
        for (int ds = 0; ds < 4; ++ds) { const bf16x8 a = *(const LAS bf16x8*)(kb + 32 * ds); p[kt] = __builtin_amdgcn_mfma_f32_32x32x16_bf16(a, qf[ds], p[kt], 0, 0, 0); }
    }
    const float NEG = -INFINITY;
    if (SWA) {
#pragma unroll
        for (int r = 0; r < 16; ++r) { const int kvl = crow(r, h); if (kvl <= ql) p[0][r] = NEG; if (kvl > ql) p[NKT - 1][r] = NEG; }
        if (blk0) {
#pragma unroll
            for (int kt = 0; kt < NKT; ++kt) if (t0 + kt < 4) {
#pragma unroll
                for (int r = 0; r < 16; ++r) p[kt][r] = NEG; }
        }
    }
    float l = 0.f;
#pragma unroll
    for (int kt = 0; kt < NKT; ++kt)
#pragma unroll
        for (int r = 0; r < 16; ++r) { p[kt][r] = __builtin_amdgcn_exp2f(p[kt][r]); l += p[kt][r]; }
    l += __shfl_xor(l, 32);
    if (SWA) l += __builtin_amdgcn_exp2f(sink2 - SOFF);
    const float inv = 1.0f / l;
    f32x16 o[2];
#pragma unroll
    for (int db = 0; db < 2; ++db)
#pragma unroll
        for (int r = 0; r < 16; ++r) o[db][r] = 0.f;
    const LAS unsigned char* vb = lds + VOFF + (4 * h + ((lane & 15) >> 2)) * ROWB + (16 * ((lane >> 4) & 1) + 4 * (lane & 3)) * 2;
#pragma unroll
    for (int kt = 0; kt < NKT; ++kt)
#pragma unroll
        for (int s = 0; s < 2; ++s) {
            u32x4 w; w.x = pk2(p[kt][8 * s], p[kt][8 * s + 1]); w.y = pk2(p[kt][8 * s + 2], p[kt][8 * s + 3]); w.z = pk2(p[kt][8 * s + 4], p[kt][8 * s + 5]); w.w = pk2(p[kt][8 * s + 6], p[kt][8 * s + 7]);
            const bf16x8 pf = __builtin_bit_cast(bf16x8, w);
            const LAS unsigned char* vp = vb + (32 * (t0 + kt) + 16 * s) * ROWB;
#pragma unroll
            for (int db = 0; db < 2; ++db) {
                const s16x4 lo = __builtin_bit_cast(s16x4, __builtin_amdgcn_ds_read_tr16_b64_v4i16((LAS s16x4*)(vp + 64 * db)));
                const s16x4 hi = __builtin_bit_cast(s16x4, __builtin_amdgcn_ds_read_tr16_b64_v4i16((LAS s16x4*)(vp + 64 * db + 8 * ROWB)));
                const bf16x8 a = (bf16x8){lo[0], lo[1], lo[2], lo[3], hi[0], hi[1], hi[2], hi[3]};
                o[db] = __builtin_amdgcn_mfma_f32_32x32x16_bf16(a, pf, o[db], 0, 0, 0);
            }
        }
    bf16* orow = Orow0 + (long)ql * ldo;
#pragma unroll
    for (int db = 0; db < 2; ++db)
#pragma unroll
        for (int g = 0; g < 4; ++g) { u32x2 w; w.x = pk2(o[db][4 * g] * inv, o[db][4 * g + 1] * inv); w.y = pk2(o[db][4 * g + 2] * inv, o[db][4 * g + 3] * inv);
            *(u32x2*)(orow + 32 * db + 8 * g + 4 * h) = w; }
}
}

__device__ __forceinline__ void conv_unit(LAS unsigned char* lds, const bf16* proj, int b, int tt, const float* w_dw, const float* b_dw, const float* g_ln, const float* b_ln, bf16* y, int tid) {
    LAS float* H = (LAS float*)lds;
    const int t0 = tt * 64;
    {
        u32x4 av[6], gv[6];
#pragma unroll
        for (int k = 0; k < 6; ++k) {
            const int idx = tid + k * NTHR, tk = idx >> 5, ch = idx & 31, t = t0 - 30 + tk;
            av[k] = (u32x4){0u, 0u, 0u, 0u}; gv[k] = av[k];
            if (idx < 94 * 32 && t >= 0) { const bf16* pp = proj + (size_t)(b * SEQ + t) * INC + 1024 + ch * 8; av[k] = *(const u32x4*)pp; gv[k] = *(const u32x4*)(pp + 256); }
        }
#pragma unroll
        for (int k = 0; k < 6; ++k) {
            const int idx = tid + k * NTHR, tk = idx >> 5, ch = idx & 31;
            float af[8], gf[8];
#pragma unroll
            for (int w = 0; w < 4; ++w) { af[2 * w] = bflo(av[k][w]); af[2 * w + 1] = bfhi(av[k][w]); gf[2 * w] = bflo(gv[k][w]); gf[2 * w + 1] = bfhi(gv[k][w]); }
#pragma unroll
            for (int i = 0; i < 8; ++i) af[i] = af[i] * __builtin_amdgcn_rcpf(1.0f + __builtin_amdgcn_exp2f(-1.4426950408889634f * gf[i]));
            if (idx < 94 * 32) { *(LAS f32x4*)(H + tk * 256 + ch * 8) = (f32x4){af[0], af[1], af[2], af[3]}; *(LAS f32x4*)(H + tk * 256 + ch * 8 + 4) = (f32x4){af[4], af[5], af[6], af[7]}; }
        }
    }
    __syncthreads();
    {
        const int cp = tid & 127, tg = tid >> 7;
        f32x2_t w2[31];
#pragma unroll
        for (int j = 0; j < 31; ++j) w2[j] = *(const f32x2_t*)(w_dw + j * 256 + 2 * cp);
        const f32x2_t bias2 = *(const f32x2_t*)(b_dw + 2 * cp);
        f32x2_t outv[16];
#pragma unroll
        for (int ck = 0; ck < 2; ++ck) {
            f32x2_t hv[38];
#pragma unroll
            for (int i = 0; i < 38; ++i) hv[i] = *(const LAS f32x2_t*)(H + (tg * 16 + ck * 8 + i) * 256 + 2 * cp);
#pragma unroll
            for (int k = 0; k < 8; ++k) { f32x2_t acc2 = bias2;
#pragma unroll
                for (int j = 0; j < 31; ++j) acc2 = __builtin_elementwise_fma(w2[j], hv[k + j], acc2);
                outv[ck * 8 + k] = acc2; }
        }
        __syncthreads();
#pragma unroll
        for (int k = 0; k < 16; ++k) *(LAS f32x2_t*)(H + (tg * 16 + k) * 256 + 2 * cp) = outv[k];
        __syncthreads();
    }
    const int wv = tid >> 6, lane = tid & 63;
    const f32x4 gg = *(const f32x4*)(g_ln + 4 * lane), bb = *(const f32x4*)(b_ln + 4 * lane);
#pragma unroll
    for (int k = 0; k < 8; ++k) {
        const int tok = wv * 8 + k; f32x4 v = *(LAS f32x4*)(H + tok * 256 + 4 * lane);
        const float mean = wave_sum((v.x + v.y) + (v.z + v.w)) * (1.0f / 256.0f);
        v = v - mean;
        const float var = wave_sum((v.x * v.x + v.y * v.y) + (v.z * v.z + v.w * v.w)) * (1.0f / 256.0f);
        const float rs = __builtin_amdgcn_rsqf(var + 1e-6f);
        v = v * rs * gg + bb;
        float o[4];
#pragma unroll
        for (int i = 0; i < 4; ++i) o[i] = v[i] * __builtin_amdgcn_rcpf(1.0f + __builtin_amdgcn_exp2f(-1.4426950408889634f * v[i]));
        u32x2 pw; pw.x = pk2(o[0], o[1]); pw.y = pk2(o[2], o[3]);
        *(u32x2*)(y + (size_t)(b * SEQ + t0 + tok) * DM + 512 + 4 * lane) = pw;
    }
    __syncthreads();
}

#define XB_TMO      128
#define XB_XCNT(j)  (256  + 64 * (j))
#define XB_XSUB(j)  (1280 + 64 * (j))
#define XB_XGEN(j)  (2304 + 64 * (j))
#define XB_TOP      3328
#define XB_TOPGEN   3392
#define XCD_BAR_WORDS 3456
#define XB_SPIN_CAP (1u << 18)

__device__ __forceinline__ unsigned xb_ld(unsigned* p)              { return __hip_atomic_load(p, __ATOMIC_RELAXED, __HIP_MEMORY_SCOPE_AGENT); }
__device__ __forceinline__ unsigned xb_add(unsigned* p, unsigned v) { return __hip_atomic_fetch_add(p, v, __ATOMIC_RELAXED, __HIP_MEMORY_SCOPE_AGENT); }
__device__ __forceinline__ unsigned xb_xcc_id() { return (unsigned)__builtin_amdgcn_s_getreg((3 << 11) | 20) & 0xFu; }
#define XB_SPIN(cond, bar) do { unsigned _sp = 0; while (cond) { __builtin_amdgcn_s_sleep(1); \
    if ((++_sp & 255u) == 0u) { if (xb_ld(&(bar)[XB_TMO])) break; if (_sp > XB_SPIN_CAP) { atomicAdd(&(bar)[XB_TMO], 1u); break; } } } } while (0)

struct XcdBarrier {
    unsigned* bar; unsigned x;
    volatile LAS unsigned* st;
};

__device__ __forceinline__ XcdBarrier xcd_barrier_post(unsigned* bar, volatile LAS unsigned* st) {
    XcdBarrier b; b.bar = bar; b.x = xb_xcc_id(); b.st = st;
    if (threadIdx.x == 0) (void)xb_add(&bar[XB_XCNT(b.x)], 1u);
    return b;
}
__device__ __forceinline__ void xcd_barrier_complete(unsigned* bar, unsigned x, unsigned& nloc, unsigned& nx) {
    const unsigned G = gridDim.x * gridDim.y * gridDim.z;
    unsigned sum, cnt, mine, sp = 0u;
    for (;;) {
        sum = 0u; cnt = 0u; mine = 0u;
#pragma unroll
        for (unsigned j = 0; j < 16; ++j) { const unsigned c = xb_ld(&bar[XB_XCNT(j)]); sum += c; cnt += (c > 0u) ? 1u : 0u; mine = (j == x) ? c : mine; }
        if (sum == G) break;
        __builtin_amdgcn_s_sleep(1);
        if ((++sp & 255u) == 0u) { if (xb_ld(&bar[XB_TMO])) break; if (sp > XB_SPIN_CAP) { atomicAdd(&bar[XB_TMO], 1u); break; } }
    }
    nloc = mine > 0u ? mine : 1u; nx = cnt > 0u ? cnt : 1u;
}

__device__ __forceinline__ void xcd_barrier(const XcdBarrier& b) {
    asm volatile("s_waitcnt vmcnt(0)" ::: "memory");
    __syncthreads();
    if (threadIdx.x == 0) {
        unsigned* bar = b.bar;
        __builtin_amdgcn_s_waitcnt(0);
        unsigned nloc = b.st[0], nx = b.st[1];
        if (nloc == 0u) { xcd_barrier_complete(bar, b.x, nloc, nx); b.st[0] = nloc; b.st[1] = nx; }
        const unsigned old = xb_add(&bar[XB_XSUB(b.x)], 1u);
        const unsigned gen = old / nloc;
        if (old + 1u == (gen + 1u) * nloc) {
            __builtin_amdgcn_fence(__ATOMIC_RELEASE, "agent");
            asm volatile("s_waitcnt vmcnt(0)" ::: "memory");
            const unsigned og = xb_add(&bar[XB_TOP], 1u);
            const unsigned tg = og / nx;
            if (og + 1u == (tg + 1u) * nx) xb_add(&bar[XB_TOPGEN], 1u);
            else XB_SPIN(xb_ld(&bar[XB_TOPGEN]) == tg, bar);
            __builtin_amdgcn_fence(__ATOMIC_ACQUIRE, "agent");
            xb_add(&bar[XB_XGEN(b.x)], 1u);
            asm volatile("s_waitcnt vmcnt(0)" ::: "memory");
        } else {
            asm volatile("buffer_inv sc1" ::: "memory");
            XB_SPIN(xb_ld(&bar[XB_XGEN(b.x)]) == gen, bar);
            asm volatile("s_waitcnt vmcnt(0)" ::: "memory");
        }
    }
    __syncthreads();
}

struct Args { const float* in[25]; float* out; unsigned char* ws; int ph_lo, ph_hi, li, pad; };
constexpr int NPHASE = 9;
__global__ void __launch_bounds__(NTHR, 2) fwd_kernel(Args a) {
    extern __shared__ __attribute__((aligned(16))) unsigned char lds_raw[];
    LAS unsigned char* lds = (LAS unsigned char*)lds_raw;
    cg::grid_group grid = cg::this_grid();
    const int tid = threadIdx.x, lane = tid & 63, wave = __builtin_amdgcn_readfirstlane(tid >> 6);
    const int G = gridDim.x, bx = blockIdx.x;
    unsigned char* ws = a.ws;
    const float* x = a.in[0]; const float* mem = a.in[1]; const int* positions = (const int*)a.in[2];
    float* ss0 = (float*)(ws + WS_SS0); float* ss1 = (float*)(ws + WS_SS1); float* ss2 = (float*)(ws + WS_SS2); float* ssm = (float*)(ws + WS_SSM);
    bf16* W1GU = (bf16*)(ws + WS_W1GU); bf16* W1D = (bf16*)(ws + WS_W1D); bf16* W2GU = (bf16*)(ws + WS_W2GU); bf16* W2D = (bf16*)(ws + WS_W2D);
    bf16* WIN = (bf16*)(ws + WS_WIN); bf16* WOUT = (bf16*)(ws + WS_WOUT); bf16* WMKV = (bf16*)(ws + WS_WMKV);
    bf16* XB = (bf16*)(ws + WS_XB); bf16* ACT = (bf16*)(ws + WS_ACT); bf16* PROJ = (bf16*)(ws + WS_PROJ); bf16* Y = (bf16*)(ws + WS_Y);
    bf16* MEMB = (bf16*)(ws + WS_MEMB); bf16* MKV = (bf16*)(ws + WS_MKV);
    const int lo = a.ph_lo, hi = a.ph_hi;
#define IN(k) (lo <= (k) && (k) < hi)
    volatile LAS unsigned* MISC = (volatile LAS unsigned*)(lds + LDS_BYTES - 128);
    if (tid < 32) MISC[tid] = 0u;
    __syncthreads();
    const XcdBarrier bar = xcd_barrier_post((unsigned*)(ws + WS_CTL) + a.li * XCD_BAR_WORDS, MISC + 8);
    if (a.ph_lo < 0) grid.sync();
#define SEAM(k) do { if (IN(k) && IN((k) + 1)) xcd_barrier(bar); } while (0)

    if (IN(0)) {
        LAS float* scr = (LAS float*)(lds + wave * 16640);
        const int gw = bx * NWAVES + wave, NGW = G * NWAVES;
        constexpr int I_GU = (DM / 64) * (DFF / 64), I_D = (DFF / 64) * (DM / 64), I_IN = (DM / 64) * (INC / 64), I_OUT = (DM / 64) * (DM / 64), I_MKV = (DM / 64) * (512 / 64);
        constexpr int NITEMS = 2 * I_GU + I_MKV, NXG = M / 4, NMG = MROWS / 4;
        for (int it = gw; it < NITEMS + NXG + NMG; it += NGW) {
            int r = it;
            if (r < I_GU) { transpose_item(a.in[4], DM, DFF, W1GU, 1, a.in[3], 1.f, scr, r, lane); continue; } r -= I_GU;
            if (r < I_GU) { transpose_item(a.in[5], DM, DFF, W1GU, 2, a.in[3], 1.f, scr, r, lane); continue; } r -= I_GU;
            if (r < I_MKV) { transpose_item(a.in[17], DM, 512, WMKV, 0, a.in[16], 1.f, scr, r, lane); continue; } r -= I_MKV;
            if (r < NXG) { rows4_to_bf16_norm(x + (size_t)r * 4 * DM, XB + (size_t)r * 4 * DM, lane); continue; } r -= NXG;
            rows4_to_bf16_norm(mem + (size_t)r * 4 * DM, MEMB + (size_t)r * 4 * DM, lane);
        }
        for (int i = bx * NTHR + tid; i < M; i += G * NTHR) ss2[i] = 0.f;
        __syncthreads();
    }
    SEAM(0);
    if (IN(1)) {
        for (int i = bx * NTHR + tid; i < M; i += G * NTHR) ss1[i] = 0.f;
        { pg8::Gemm g{XB, W1GU, M, 2 * DFF, DM, 2 * DM, 128, 128, 32768}; pg8::StaticOrder S; S.init(M, 2 * DFF, G, bx); pg8::EpiSwiGLU<false> E{ACT, DFF, nullptr};
          pg8::gemm_phase<pg8::EpiSwiGLU<false>, pg8::StaticOrder, true, true>(lds, g, S, E); }
        { pg8::Gemm g{MEMB, WMKV, MROWS, 512, DM, 2 * DM, 128, 128, 32768}; pg8::ExtraOrder S{bx, G >= 160 ? 128 : 0, 2, 16}; pg8::EpiScaleBf16<false> E{MKV, 512, nullptr};
          pg8::gemm_phase<pg8::EpiScaleBf16<false>, pg8::ExtraOrder, true, true>(lds, g, S, E); }
        {
            const int c0 = G >= 160 ? 144 : 0;
            if (bx >= c0) {
                LAS float* scr = (LAS float*)(lds + wave * 16640);
                constexpr int I_GU = (DM / 64) * (DFF / 64), I_D = (DFF / 64) * (DM / 64), I_IN = (DM / 64) * (INC / 64), I_OUT = (DM / 64) * (DM / 64);
                for (int it = (bx - c0) * NWAVES + wave; it < 2 * I_GU + 2 * I_D + I_IN + I_OUT; it += (G - c0) * NWAVES) {
                    int r = it;
                    if (r < I_D) { transpose_item(a.in[6], DFF, DM, W1D, 0, nullptr, 0.5f, scr, r, lane); continue; } r -= I_D;
                    if (r < I_IN) { transpose_item(a.in[8], DM, INC, WIN, 3, a.in[7], 1.f, scr, r, lane); continue; } r -= I_IN;
                    if (r < I_OUT) { transpose_item(a.in[20], DM, DM, WOUT, 0, nullptr, 1.f, scr, r, lane); continue; } r -= I_OUT;
                    if (r < I_GU) { transpose_item(a.in[22], DM, DFF, W2GU, 1, a.in[21], 1.f, scr, r, lane); continue; } r -= I_GU;
                    if (r < I_GU) { transpose_item(a.in[23], DM, DFF, W2GU, 2, a.in[21], 1.f, scr, r, lane); continue; } r -= I_GU;
                    transpose_item(a.in[24], DFF, DM, W2D, 0, nullptr, 0.5f, scr, r, lane);
                }
            }
        }
    }
    SEAM(1);
    if (IN(2)) {
        pg8::Gemm g{ACT, W1D, M, DM, DFF, 128, 32768, 128, 32768}; pg8::StaticOrder S; S.init(M, DM, G, bx); pg8::EpiResid<0> E{x, nullptr, XB, ss1};
        pg8::gemm_phase<pg8::EpiResid<0>, pg8::StaticOrder, true, true>(lds, g, S, E);
    }
    SEAM(2);
    if (IN(3)) {
        pg8::Gemm g{XB, WIN, M, 1024, DM, 2 * DM, 128, 128, 32768}; pg8::StaticOrder S; S.init(M, 1024, G, bx); pg8::EpiScaleBf16<true> E{PROJ, INC, ss1};
        pg8::gemm_phase<pg8::EpiScaleBf16<true>, pg8::StaticOrder, true, true>(lds, g, S, E);
    }
    SEAM(3);
#define SWA_UNIT(u_) do { const int u = (u_); const int b = u >> 5, g = (u >> 4) & 1, n = u & 15; \
            const long krow0 = (long)b * SEQ + (n - 1) * 128; const int hq = g * 4 + (wave >> 1); const long qrow = (long)b * SEQ + n * 128 + 64 * (wave & 1); \
            u32x4 kr[4], vr[4], raw0[4], raw1[4]; \
            att::kv_issue(kr, vr, PROJ + krow0 * INC + 512 + g * 64, PROJ + krow0 * INC + 640 + g * 64, INC, n == 0 ? 128 : 0, tid); \
            att::q_issue(raw0, PROJ + qrow * INC + hq * 64, INC, lane); att::q_issue(raw1, PROJ + (qrow + 32) * INC + hq * 64, INC, lane); \
            const int kpos = ((tid >> 1) >= (n == 0 ? 128 : 0)) ? positions[krow0 + (tid >> 1)] : 0; const int qp0 = positions[qrow + (lane & 31)], qp1 = positions[qrow + 32 + (lane & 31)]; \
            f32x4 g0[2]; g0[0] = *(const f32x4*)(a.in[9] + 8 * (lane >> 5)); g0[1] = *(const f32x4*)(a.in[9] + 8 * (lane >> 5) + 4); \
            const float sink2 = a.in[11][hq] * att::LOG2E; \
            att::kv_finish<true>(lds, kr, vr, a.in[10], a.in[9], (float)kpos, tid); \
            __syncthreads(); \
            att::attn_wave<5, true>(lds, raw0, g0, (float)qp0, sink2, 2 * (wave & 1), n == 0, Y + qrow * DM + hq * 64, DM, lane); \
            att::attn_wave<5, true>(lds, raw1, g0, (float)qp1, sink2, 2 * (wave & 1) + 1, n == 0, Y + (qrow + 32) * DM + hq * 64, DM, lane); \
            __syncthreads(); } while (0)
#define MEM_UNIT(u_) do { const int u = (u_); const int b = u >> 5, hm = (u >> 3) & 3, qt = u & 7; \
            const long qrow = (long)b * SEQ + qt * 256 + 32 * wave; \
            u32x4 kr[4], vr[4], raw0[4]; \
            att::kv_issue(kr, vr, MKV + (long)b * MEML * 512 + hm * 64, MKV + (long)b * MEML * 512 + 256 + hm * 64, 512, 0, tid); \
            att::q_issue(raw0, PROJ + qrow * INC + 768 + hm * 64, INC, lane); \
            f32x4 g0[2]; g0[0] = (f32x4){1.f, 1.f, 1.f, 1.f}; g0[1] = g0[0]; \
            att::kv_finish<false>(lds, kr, vr, a.in[19], a.in[18], 0.f, tid); \
            __syncthreads(); \
            att::attn_wave<8, false>(lds, raw0, g0, 0.f, 0.f, 0, false, Y + qrow * DM + 768 + hm * 64, DM, lane); \
            __syncthreads(); } while (0)
    if (IN(4)) {
        { pg8::Gemm g{XB, WIN + (size_t)1024 * DM, M, 512, DM, 2 * DM, 128, 128, 32768}; pg8::StaticOrder S; S.init(M, 512, G, bx); pg8::EpiScaleBf16<true> E{PROJ + 1024, INC, ss1};
          pg8::gemm_phase<pg8::EpiScaleBf16<true>, pg8::StaticOrder, true, true>(lds, g, S, E); }
        if (G == 256) {
            if (bx < 128) { MEM_UNIT(128 + bx); }
            else { SWA_UNIT(bx - 128); SWA_UNIT(bx); MEM_UNIT(bx - 128); }
        } else {
#pragma unroll 1
            for (int u = bx; u < 256; u += G) SWA_UNIT(u);
#pragma unroll 1
            for (int u = bx; u < 256; u += G) MEM_UNIT(u);
        }
    }
    SEAM(4);
    if (IN(5)) {
#pragma unroll 1
        for (int u = bx; u < 256; u += G) conv_unit(lds, PROJ, u >> 5, u & 31, a.in[12], a.in[13], a.in[14], a.in[15], Y, tid);
    }
    SEAM(5);
    if (IN(6)) {
        pg8::Gemm g{Y, WOUT, M, DM, DM, 2 * DM, 128, 128, 32768}; pg8::StaticOrder S; S.init(M, DM, G, bx); pg8::EpiResid<1> E{nullptr, nullptr, XB, ss2};
        pg8::gemm_phase<pg8::EpiResid<1>, pg8::StaticOrder, true, true>(lds, g, S, E);
    }
    SEAM(6);
    if (IN(7)) {
        pg8::Gemm g{XB, W2GU, M, 2 * DFF, DM, 2 * DM, 128, 128, 32768}; pg8::StaticOrder S; S.init(M, 2 * DFF, G, bx); pg8::EpiSwiGLU<true> E{ACT, DFF, ss2};
        pg8::gemm_phase<pg8::EpiSwiGLU<true>, pg8::StaticOrder, true, true>(lds, g, S, E);
    }
    SEAM(7);
    if (IN(8)) {
        pg8::Gemm g{ACT, W2D, M, DM, DFF, 128, 32768, 128, 32768}; pg8::StaticOrder S; S.init(M, DM, G, bx); pg8::EpiResid<2> E{nullptr, a.out, XB, nullptr};
        pg8::gemm_phase<pg8::EpiResid<2>, pg8::StaticOrder, true, true>(lds, g, S, E);
    }
#undef IN
#undef SEAM
}

extern "C" void kernel_launch(void* const* d_in, const int* in_sizes, int n_in, void* d_out, int out_size, void* d_ws, size_t ws_size, hipStream_t stream) {
    static int grid = 0;
    if (grid == 0) {
        int dev = 0, cus = 0, per_cu = 0;
        if (n_in != 25 || out_size != M * DM || ws_size < WS_END) { fprintf(stderr, "kernel_launch: unexpected shapes (n_in %d out %d ws %zu)\n", n_in, out_size, ws_size); grid = -1; return; }
        (void)hipGetDevice(&dev); (void)hipDeviceGetAttribute(&cus, hipDeviceAttributeMultiprocessorCount, dev);
        (void)hipFuncSetAttribute((const void*)fwd_kernel, hipFuncAttributeMaxDynamicSharedMemorySize, LDS_BYTES);
        (void)hipOccupancyMaxActiveBlocksPerMultiprocessor(&per_cu, (const void*)fwd_kernel, NTHR, LDS_BYTES);
        if (per_cu < 1) { fprintf(stderr, "kernel_launch: occupancy query says %d blocks per CU\n", per_cu); per_cu = 1; }
        (void)hipGetLastError();
        grid = cus;
    }
    if (grid < 0) return;
    if (hipMemsetAsync((char*)d_ws + WS_CTL, 0, CTL_BYTES, stream) != hipSuccess) { fprintf(stderr, "kernel_launch: memset failed\n"); return; }
    Args a{};
    for (int i = 0; i < 25; ++i) a.in[i] = (const float*)d_in[i];
    a.out = (float*)d_out; a.ws = (unsigned char*)d_ws;
    a.ph_lo = 0; a.ph_hi = NPHASE; a.li = 0;
    {
        void* args[] = {&a};
        hipError_t e = hipLaunchCooperativeKernel((const void*)fwd_kernel, dim3(grid), dim3(NTHR), args, LDS_BYTES, stream);
        if (e != hipSuccess) { fprintf(stderr, "kernel_launch: cooperative launch failed: %s (grid %d)\n", hipGetErrorString(e), grid); }
    }
}
```

```cpp
#include <hip/hip_runtime.h>
#include <hip/hip_cooperative_groups.h>
#include <cstdio>
#include <cstdint>
namespace cg = cooperative_groups;
namespace pg8 {
#define PG8_LAS __attribute__((address_space(3)))
typedef unsigned short bf16_t;
typedef short bf16x8 __attribute__((ext_vector_type(8)));
typedef float f32x4 __attribute__((ext_vector_type(4)));
typedef unsigned u32x4 __attribute__((ext_vector_type(4)));
constexpr int BM = 256, BK = 64, HALF = 128, HTB = HALF * BK * 2  , STAGE_BYTES = 8 * HTB, NXCD = 8, WGM = 8;

__host__ __device__ __forceinline__ int lds_byte(int r, int c) { const int st = (r >> 4) * 2 + (c >> 5), rr = r & 15, cc = c & 31, ob = rr * 64 + cc * 2; return st * 1024 + (ob ^ (((ob >> 9) & 1) << 5)); }
__host__ __device__ __forceinline__ void stage_rc(int b, int& R, int& C) { const int st = b / 1024, sb = b % 1024, swz = sb ^ (((sb >> 9) & 1) << 5); R = (st >> 1) * 16 + swz / 64; C = (st & 1) * 32 + (swz % 64) / 2; }
__host__ __device__ __forceinline__ int perm32(int rho) { const int n = rho >> 4, i = rho & 15; return 8 * (i >> 2) + 4 * n + (i & 3); }

struct Unit { int pm, pn; };
struct Gemm { const bf16_t* A; const bf16_t* Bt; int M, N, K; int apitch, akstep, bpitch, bkstep; };

struct StaticOrder {
    int nM, nN, nwg, G, c;
    __host__ __device__ void init(int M, int N, int G_, int c_) { nM = M / BM; nN = N / BM; nwg = nM * nN; G = G_; c = c_; }
    __host__ __device__ bool next(int i, Unit& u) const {
        const long L = (long)i * G + c; if (L >= nwg) return false;
        int wgid = (int)L; { const int q = nwg / NXCD, r = nwg % NXCD, xcd = wgid % NXCD, off = wgid / NXCD; wgid = (xcd < r ? xcd * (q + 1) : r * (q + 1) + (xcd - r) * q) + off; }
        const int nig = WGM * nN, gid = wgid / nig, fm = gid * WGM, gsz = (nM - fm) < WGM ? (nM - fm) : WGM;
        u.pm = fm + ((wgid % nig) % gsz); u.pn = (wgid % nig) / gsz; return true;
    }
    __device__ __forceinline__ void a_ready(const Unit&) const {}
    __device__ __forceinline__ void done(const Unit&) const {}
};

__device__ __forceinline__ unsigned cvt_pk_bf16(float lo, float hi) { unsigned r; asm volatile("v_cvt_pk_bf16_f32 %0, %1, %2" : "=v"(r) : "v"(lo), "v"(hi)); return r; }
__device__ __forceinline__ void st16_wt(const void* base, unsigned off, u32x4 v) {
    __amdgpu_buffer_rsrc_t r = __builtin_amdgcn_make_buffer_rsrc(const_cast<void*>(base), 0, 0x7fffffff, 0x00020000);
    __builtin_amdgcn_raw_buffer_store_b128(v, r, (int)off, 0, 16);
}
__device__ __forceinline__ void st16_wt(const void* base, unsigned off, f32x4 v) { st16_wt(base, off, __builtin_bit_cast(u32x4, v)); }
typedef float f32x2 __attribute__((ext_vector_type(2)));
template <class Epi, class Sched, bool ALIGN_EPI = false, bool SP2 = false>
__device__ __forceinline__ void gemm_phase(PG8_LAS unsigned char* lds, const Gemm g, const Sched& S, const Epi& E) {
    const int tid = threadIdx.x, wid = __builtin_amdgcn_readfirstlane(tid >> 6), lane = tid & 63, wr = wid >> 2, wc = wid & 3, fr = lane & 15, fq = lane >> 4;
    const int K = g.K, nt = K / BK;
    unsigned voffA[2], voffB[2];
#pragma unroll
    for (int i = 0; i < 2; ++i) { int R, C; stage_rc(tid * 16 + i * 8192, R, C); const int Rb = Epi::PERM ? ((R & ~31) + perm32(R & 31)) : R;
        voffA[i] = (unsigned)(R * g.apitch + C * 2); voffB[i] = (unsigned)(Rb * g.bpitch + C * 2); }
    const size_t kstepA = (size_t)g.akstep, kstepB = (size_t)g.bkstep;
    const size_t hstepA = (size_t)HALF * g.apitch, hstepB = (size_t)HALF * g.bpitch;
    const size_t tstep = (size_t)BM * K * 2;
    const unsigned ldsw = (unsigned)wid * 1024u;
    const int aoff = lds_byte(wr * 64 + fr, fq * 8), boff = lds_byte(wc * 32 + fr, fq * 8);
#define PG8_SA(b, h) (((b) * 2 + (h)) * HTB)
#define PG8_SB(b, h) ((4 + (b) * 2 + (h)) * HTB)
#define PG8_STAGE(bufoff, gbase, voff) do { _Pragma("unroll") for (int _i = 0; _i < 2; ++_i) \
        __builtin_amdgcn_global_load_lds((const unsigned*)((const char*)(gbase) + (voff)[_i]), (PG8_LAS unsigned*)(lds + (bufoff) + ldsw + _i * 8192), 16, 0, 0); } while (0)
#define PG8_LDA(dst, b, h) do { _Pragma("unroll") for (int m = 0; m < 4; ++m) _Pragma("unroll") for (int k = 0; k < 2; ++k) dst[m][k] = *(const PG8_LAS bf16x8*)(lds + PG8_SA(b, h) + aoff + m * 2048 + k * 1024); } while (0)
#define PG8_LDB(dst, b, h) do { _Pragma("unroll") for (int n = 0; n < 2; ++n) _Pragma("unroll") for (int k = 0; k < 2; ++k) dst[n][k] = *(const PG8_LAS bf16x8*)(lds + PG8_SB(b, h) + boff + n * 2048 + k * 1024); } while (0)
#define PG8_MMA(ai, bj, At, Bt) do { __builtin_amdgcn_s_setprio(1); _Pragma("unroll") for (int m = 0; m < 4; ++m) _Pragma("unroll") for (int n = 0; n < 2; ++n) _Pragma("unroll") for (int k = 0; k < 2; ++k) \
        acc[ai][bj][m][n] = __builtin_amdgcn_mfma_f32_16x16x32_bf16(Bt[n][k], At[m][k], acc[ai][bj][m][n], 0, 0, 0); __builtin_amdgcn_s_setprio(0); } while (0)
#define PG8_WAIT_V(n) asm volatile("s_waitcnt vmcnt(" #n ")" ::: "memory")
#define PG8_WAIT_L(n) asm volatile("s_waitcnt lgkmcnt(" #n ")" ::: "memory")
#define PG8_BAR __builtin_amdgcn_s_barrier()
#define PG8_SCHED __builtin_amdgcn_sched_barrier(0)
    Unit cur, nxt; int ui = 0;
    if (!S.next(0, cur)) return;
    float epre[8]; E.prefetch(epre, cur, wr, fr);
    f32x4 acc[2][2][4][2];
#pragma unroll
    for (int a = 0; a < 2; ++a)
#pragma unroll
        for (int b = 0; b < 2; ++b)
#pragma unroll
            for (int m = 0; m < 4; ++m)
#pragma unroll
                for (int n = 0; n < 2; ++n) acc[a][b][m][n] = (f32x4){0.f, 0.f, 0.f, 0.f};
    bf16x8 At[4][2], B0[2][2], B1[2][2];
    const char* cA = (const char*)g.A + (size_t)cur.pm * tstep; const char* cB = (const char*)g.Bt + (size_t)cur.pn * tstep;
    S.a_ready(cur);
    if constexpr (SP2) {
        PG8_STAGE(PG8_SB(0, 0), cB, voffB); PG8_STAGE(PG8_SB(0, 1), cB + hstepB, voffB); PG8_STAGE(PG8_SA(0, 0), cA, voffA); PG8_STAGE(PG8_SA(0, 1), cA + hstepA, voffA);
        if (wr == 1) PG8_BAR;
        PG8_WAIT_V(2); PG8_BAR;
        PG8_STAGE(PG8_SB(1, 0), cB + kstepB, voffB); PG8_STAGE(PG8_SA(1, 0), cA + kstepA, voffA); PG8_STAGE(PG8_SB(1, 1), cB + hstepB + kstepB, voffB);
        PG8_WAIT_V(6); PG8_BAR;
    } else {
        PG8_STAGE(PG8_SB(0, 0), cB, voffB); PG8_STAGE(PG8_SA(0, 0), cA, voffA); PG8_STAGE(PG8_SB(0, 1), cB + hstepB, voffB); PG8_STAGE(PG8_SA(0, 1), cA + hstepA, voffA);
        if (wr == 1) PG8_BAR;
        PG8_WAIT_V(4); PG8_BAR;
        PG8_STAGE(PG8_SB(1, 0), cB + kstepB, voffB); PG8_STAGE(PG8_SA(1, 0), cA + kstepA, voffA); PG8_STAGE(PG8_SB(1, 1), cB + hstepB + kstepB, voffB);
        PG8_WAIT_V(6); PG8_BAR;
    }
    for (;;) {
        const bool has_next = S.next(ui + 1, nxt);
        const char* nA = has_next ? (const char*)g.A + (size_t)nxt.pm * tstep : cA; const char* nB = has_next ? (const char*)g.Bt + (size_t)nxt.pn * tstep : cB;
        for (int t = 0; t < nt; t += 2) {
            const bool last = (t == nt - 2);
            const char* a1 = cA + (size_t)(t + 1) * kstepA;
            const char* a2 = last ? nA : cA + (size_t)(t + 2) * kstepA; const char* b2 = last ? nB : cB + (size_t)(t + 2) * kstepB;
            const char* a3 = a2 + kstepA; const char* b3 = b2 + kstepB;
            if (last && has_next) S.a_ready(nxt);
            if constexpr (SP2) {
            PG8_LDB(B0, 0, 0); PG8_LDB(B1, 0, 1); PG8_SCHED; PG8_LDA(At, 0, 0); PG8_STAGE(PG8_SA(1, 1), a1 + hstepA, voffA);
            PG8_WAIT_V(8); PG8_WAIT_L(0); PG8_BAR; PG8_MMA(0, 0, At, B0); PG8_MMA(0, 1, At, B1); PG8_BAR; PG8_SCHED;
            PG8_LDA(At, 0, 1); PG8_STAGE(PG8_SB(0, 0), b2, voffB); PG8_STAGE(PG8_SB(0, 1), b2 + hstepB, voffB); PG8_STAGE(PG8_SA(0, 0), a2, voffA);
            PG8_WAIT_V(8); PG8_WAIT_L(0); PG8_BAR; PG8_MMA(1, 0, At, B0); PG8_MMA(1, 1, At, B1); PG8_BAR; PG8_SCHED;
            PG8_LDB(B0, 1, 0); PG8_LDB(B1, 1, 1); PG8_SCHED; PG8_LDA(At, 1, 0); PG8_STAGE(PG8_SA(0, 1), a2 + hstepA, voffA);
            PG8_WAIT_V(8); PG8_WAIT_L(0); PG8_BAR; PG8_MMA(0, 0, At, B0); PG8_MMA(0, 1, At, B1); PG8_BAR; PG8_SCHED;
            PG8_LDA(At, 1, 1); PG8_STAGE(PG8_SB(1, 0), b3, voffB); PG8_STAGE(PG8_SB(1, 1), b3 + hstepB, voffB); PG8_STAGE(PG8_SA(1, 0), a3, voffA);
            PG8_WAIT_V(8); PG8_WAIT_L(0); PG8_BAR; PG8_MMA(1, 0, At, B0); PG8_MMA(1, 1, At, B1); PG8_BAR; PG8_SCHED;
            } else {
            PG8_LDB(B0, 0, 0); PG8_SCHED; PG8_LDA(At, 0, 0); PG8_STAGE(PG8_SA(1, 1), a1 + hstepA, voffA);
            PG8_WAIT_L(8); PG8_BAR; PG8_WAIT_L(0); PG8_MMA(0, 0, At, B0); PG8_BAR; PG8_SCHED;
            PG8_LDB(B1, 0, 1); PG8_STAGE(PG8_SB(0, 0), b2, voffB);
            PG8_BAR; PG8_WAIT_L(0); PG8_MMA(0, 1, At, B1); PG8_BAR;
            PG8_LDA(At, 0, 1); PG8_STAGE(PG8_SA(0, 0), a2, voffA);
            PG8_BAR; PG8_WAIT_L(0); PG8_MMA(1, 0, At, B0); PG8_BAR; PG8_SCHED;
            PG8_STAGE(PG8_SB(0, 1), b2 + hstepB, voffB);
            PG8_WAIT_V(6); PG8_BAR; PG8_MMA(1, 1, At, B1); PG8_BAR;
            PG8_LDB(B0, 1, 0); PG8_SCHED; PG8_LDA(At, 1, 0); PG8_STAGE(PG8_SA(0, 1), a2 + hstepA, voffA);
            PG8_WAIT_L(8); PG8_BAR; PG8_WAIT_L(0); PG8_MMA(0, 0, At, B0); PG8_BAR; PG8_SCHED;
            PG8_LDB(B1, 1, 1); PG8_STAGE(PG8_SB(1, 0), b3, voffB);
            PG8_BAR; PG8_WAIT_L(0); PG8_MMA(0, 1, At, B1); PG8_BAR;
            PG8_LDA(At, 1, 1); PG8_STAGE(PG8_SA(1, 0), a3, voffA);
            PG8_BAR; PG8_WAIT_L(0); PG8_MMA(1, 0, At, B0); PG8_BAR; PG8_SCHED;
            PG8_STAGE(PG8_SB(1, 1), b3 + hstepB, voffB);
            PG8_WAIT_V(6); PG8_BAR; PG8_MMA(1, 1, At, B1); PG8_BAR;
            }
        }
        if constexpr (ALIGN_EPI) { if (wr == 0) PG8_BAR; }
        if constexpr (!Epi::AFTER_DRAIN) { E(acc, cur, wr, wc, fr, fq, epre); S.done(cur); if (has_next) E.prefetch(epre, nxt, wr, fr); }
        if (!has_next) break;
#pragma unroll
        for (int a = 0; a < 2; ++a)
#pragma unroll
            for (int b = 0; b < 2; ++b)
#pragma unroll
                for (int m = 0; m < 4; ++m)
#pragma unroll
                    for (int n = 0; n < 2; ++n) acc[a][b][m][n] = (f32x4){0.f, 0.f, 0.f, 0.f};
        cur = nxt; cA = nA; cB = nB; ++ui;
        if constexpr (ALIGN_EPI) { if (wr == 1) PG8_BAR; }
    }
    PG8_WAIT_V(0);
    if constexpr (!ALIGN_EPI) { if (wr == 0) PG8_BAR; }
    PG8_BAR;
    if constexpr (Epi::AFTER_DRAIN) { E.fused(acc, cur, wr, wc, fr, fq, lds, wid, lane); S.done(cur); }
#undef PG8_SA
#undef PG8_SB
#undef PG8_STAGE
#undef PG8_LDA
#undef PG8_LDB
#undef PG8_MMA
#undef PG8_WAIT_V
#undef PG8_WAIT_L
#undef PG8_BAR
#undef PG8_SCHED
}
}
namespace pg8 {
__device__ __forceinline__ float rstd_of(float ss) { return __builtin_amdgcn_rsqf(ss * (1.0f / 1024.0f) + 1e-6f); }
__device__ __forceinline__ float silu_mul(float g, float u) { return g * __builtin_amdgcn_rcpf(1.0f + __builtin_amdgcn_exp2f(-1.4426950408889634f * g)) * u; }
template <bool SS> struct EpiSwiGLU {
    static constexpr bool PERM = true, AFTER_DRAIN = false;
    bf16_t* O; int ldc; const float* ss;
    __device__ __forceinline__ void prefetch(float (&pre)[8], const Unit& u, int wr, int fr) const {
        const int row0 = u.pm * BM + wr * 64 + fr;
#pragma unroll
        for (int i = 0; i < 8; ++i) pre[i] = SS ? ss[row0 + (i >> 2) * HALF + (i & 3) * 16] : 1.f;
    }
    __device__ __forceinline__ void operator()(const f32x4 (&acc)[2][2][4][2], const Unit& u, int wr, int wc, int fr, int fq, const float (&pre)[8]) const {
        const int row0 = u.pm * BM + wr * 64 + fr, col0 = u.pn * HALF + wc * 32 + 8 * fq;
        float rsv[8];
#pragma unroll
        for (int i = 0; i < 8; ++i) rsv[i] = pre[i];
        if (SS) {
#pragma unroll
            for (int i = 0; i < 8; ++i) rsv[i] = rstd_of(rsv[i]); }
#pragma unroll
        for (int ai = 0; ai < 2; ++ai)
#pragma unroll
            for (int m = 0; m < 4; ++m) {
                const int row = row0 + ai * HALF + m * 16; const float rs = rsv[ai * 4 + m];
                typedef float f32x2 __attribute__((ext_vector_type(2)));
                u32x4 w;
#pragma unroll
                for (int n = 0; n < 2; ++n) {
                    const f32x4 gq = acc[ai][0][m][n], uq = acc[ai][1][m][n];
#pragma unroll
                    for (int hh = 0; hh < 2; ++hh) {
                        f32x2 g = (f32x2){gq[2 * hh], gq[2 * hh + 1]}, uu = (f32x2){uq[2 * hh], uq[2 * hh + 1]};
                        if (SS) { g = g * rs; uu = uu * rs; }
                        const f32x2 t = g * (-1.4426950408889634f);
                        f32x2 e; e.x = __builtin_amdgcn_exp2f(t.x); e.y = __builtin_amdgcn_exp2f(t.y);
                        const f32x2 d = e + 1.0f;
                        f32x2 r; r.x = __builtin_amdgcn_rcpf(d.x); r.y = __builtin_amdgcn_rcpf(d.y);
                        const f32x2 o = (g * uu) * r;
                        w[2 * n + hh] = cvt_pk_bf16(o.x, o.y);
                    }
                }
                st16_wt(O, (unsigned)((((size_t)u.pm * (ldc >> 6) + (col0 >> 6)) * 256 + (row & 255)) * 64 + (col0 & 63)) * 2u, w);
            }
    }
};
struct EpiGLU {
    static constexpr bool PERM = true, AFTER_DRAIN = false;
    bf16_t* O; int ldc; const float* ss;
    __device__ __forceinline__ void prefetch(float (&pre)[8], const Unit& u, int wr, int fr) const {
        const int row0 = u.pm * BM + wr * 64 + fr;
#pragma unroll
        for (int i = 0; i < 8; ++i) pre[i] = ss[row0 + (i >> 2) * HALF + (i & 3) * 16];
    }
    __device__ __forceinline__ void operator()(const f32x4 (&acc)[2][2][4][2], const Unit& u, int wr, int wc, int fr, int fq, const float (&pre)[8]) const {
        const int row0 = u.pm * BM + wr * 64 + fr, col0 = u.pn * HALF + wc * 32 + 8 * fq;
#pragma unroll
        for (int ai = 0; ai < 2; ++ai)
#pragma unroll
            for (int m = 0; m < 4; ++m) {
                const int row = row0 + ai * HALF + m * 16; const float rs = rstd_of(pre[ai * 4 + m]);
                u32x4 w;
#pragma unroll
                for (int n = 0; n < 2; ++n) {
                    const f32x4 aq = acc[ai][0][m][n] * rs, gq = acc[ai][1][m][n] * rs;
                    float o[4];
#pragma unroll
                    for (int i = 0; i < 4; ++i) o[i] = aq[i] * __builtin_amdgcn_rcpf(1.0f + __builtin_amdgcn_exp2f(-1.4426950408889634f * gq[i]));
                    w[2 * n] = cvt_pk_bf16(o[0], o[1]); w[2 * n + 1] = cvt_pk_bf16(o[2], o[3]);
                }
                *(u32x4*)(O + (size_t)row * ldc + col0) = w;
            }
    }
};
template <bool SS> struct EpiScaleBf16 {
    static constexpr bool PERM = true, AFTER_DRAIN = false;
    bf16_t* O; int ldc; const float* ss;
    __device__ __forceinline__ void prefetch(float (&pre)[8], const Unit& u, int wr, int fr) const {
        const int row0 = u.pm * BM + wr * 64 + fr;
#pragma unroll
        for (int i = 0; i < 8; ++i) pre[i] = SS ? ss[row0 + (i >> 2) * HALF + (i & 3) * 16] : 1.f;
    }
    __device__ __forceinline__ void operator()(const f32x4 (&acc)[2][2][4][2], const Unit& u, int wr, int wc, int fr, int fq, const float (&pre)[8]) const {
        const int row0 = u.pm * BM + wr * 64 + fr, col0 = u.pn * BM + wc * 32 + 8 * fq;
        float rsv[8];
#pragma unroll
        for (int i = 0; i < 8; ++i) rsv[i] = pre[i];
        if (SS) {
#pragma unroll
            for (int i = 0; i < 8; ++i) rsv[i] = rstd_of(rsv[i]); }
#pragma unroll
        for (int ai = 0; ai < 2; ++ai)
#pragma unroll
            for (int m = 0; m < 4; ++m) {
                const int row = row0 + ai * HALF + m * 16; const float rs = rsv[ai * 4 + m];
#pragma unroll
                for (int bj = 0; bj < 2; ++bj) {
                    const f32x4 v0 = acc[ai][bj][m][0] * rs, v1 = acc[ai][bj][m][1] * rs; u32x4 w;
                    w.x = cvt_pk_bf16(v0[0], v0[1]); w.y = cvt_pk_bf16(v0[2], v0[3]); w.z = cvt_pk_bf16(v1[0], v1[1]); w.w = cvt_pk_bf16(v1[2], v1[3]);
                    st16_wt(O, (unsigned)((size_t)row * ldc + col0 + bj * HALF) * 2u, w);
                }
            }
    }
};
template <int MODE> struct EpiResid {
    static constexpr bool PERM = true, AFTER_DRAIN = false;
    const float* base; float* out; bf16_t* xb; float* ssn;
    __device__ __forceinline__ void prefetch(float (&)[8], const Unit&, int, int) const {}
    __device__ __forceinline__ void operator()(const f32x4 (&acc)[2][2][4][2], const Unit& u, int wr, int wc, int fr, int fq, const float (&)[8]) const {
        const int row0 = u.pm * BM + wr * 64 + fr, col0 = u.pn * BM + wc * 32 + 8 * fq;
        f32x4 pre[2][2][2]; u32x4 preb[2][2];
#define EPR_LOAD(slot, it) do { const size_t off_ = (size_t)(row0 + ((it) >> 2) * HALF + ((it) & 3) * 16) * 1024 + col0; \
        if (MODE == 0) { pre[slot][0][0] = __builtin_nontemporal_load((const f32x4*)(base + off_)); pre[slot][0][1] = __builtin_nontemporal_load((const f32x4*)(base + off_ + 4)); pre[slot][1][0] = __builtin_nontemporal_load((const f32x4*)(base + off_ + HALF)); pre[slot][1][1] = __builtin_nontemporal_load((const f32x4*)(base + off_ + HALF + 4)); } \
        else { preb[slot][0] = *(const u32x4*)(xb + off_); preb[slot][1] = *(const u32x4*)(xb + off_ + HALF); } } while (0)
        EPR_LOAD(0, 0); EPR_LOAD(1, 1);
        float sacc[8];
#pragma unroll
        for (int it = 0; it < 8; ++it) {
            const int ai = it >> 2, m = it & 3, row = row0 + ai * HALF + m * 16; float s = 0.f;
            f32x4 v[2][2];
#pragma unroll
            for (int bj = 0; bj < 2; ++bj) {
                f32x4 b0, b1;
                if (MODE == 0) { b0 = pre[it & 1][bj][0]; b1 = pre[it & 1][bj][1]; }
                else { const u32x4 w = preb[it & 1][bj]; b0 = (f32x4){__uint_as_float(w.x << 16), __uint_as_float(w.x & 0xffff0000u), __uint_as_float(w.y << 16), __uint_as_float(w.y & 0xffff0000u)};
                       b1 = (f32x4){__uint_as_float(w.z << 16), __uint_as_float(w.z & 0xffff0000u), __uint_as_float(w.w << 16), __uint_as_float(w.w & 0xffff0000u)}; }
                v[bj][0] = b0 + acc[ai][bj][m][0]; v[bj][1] = b1 + acc[ai][bj][m][1]; }
            if (it + 2 < 8) EPR_LOAD(it & 1, it + 2);
#pragma unroll
            for (int bj = 0; bj < 2; ++bj) {
                const size_t off = (size_t)row * 1024 + col0 + bj * HALF; const f32x4 v0 = v[bj][0], v1 = v[bj][1];
                if (MODE == 2) { *(f32x4*)(out + off) = v0; *(f32x4*)(out + off + 4) = v1; }
                else {
                    s += (v0[0] * v0[0] + v0[1] * v0[1]) + (v0[2] * v0[2] + v0[3] * v0[3]) + (v1[0] * v1[0] + v1[1] * v1[1]) + (v1[2] * v1[2] + v1[3] * v1[3]);
                    u32x4 w; w.x = cvt_pk_bf16(v0[0], v0[1]); w.y = cvt_pk_bf16(v0[2], v0[3]); w.z = cvt_pk_bf16(v1[0], v1[1]); w.w = cvt_pk_bf16(v1[2], v1[3]);
                    st16_wt(xb, (unsigned)off * 2u, w);
                }
            }
            sacc[it] = s;
        }
#undef EPR_LOAD
        if (MODE != 2) {
#pragma unroll
            for (int it = 0; it < 8; ++it) { float s = sacc[it]; s += __shfl_xor(s, 16); s += __shfl_xor(s, 32); if (fq == 0) unsafeAtomicAdd(ssn + row0 + (it >> 2) * HALF + (it & 3) * 16, s); }
        }
    }
};
struct ExtraOrder {
    int c, c0, nN, n;
    __device__ bool next(int i, Unit& u) const { const int k = c - c0; if (i > 0 || k < 0 || k >= n) return false; u.pm = k / nN; u.pn = k % nN; return true; }
    __device__ __forceinline__ void a_ready(const Unit&) const {}
    __device__ __forceinline__ void done(const Unit&) const {}
};
}

constexpr int BATCH = 8, SEQ = 2048, DM = 1024, M = BATCH * SEQ, DFF = 2816, INC = 1536, MEML = 256, MROWS = BATCH * MEML;
constexpr int NWAVES = 8, NTHR = 512;
#define LAS __attribute__((address_space(3)))
typedef unsigned short bf16;
typedef unsigned u32x4 __attribute__((ext_vector_type(4)));
typedef unsigned u32x2 __attribute__((ext_vector_type(2)));
typedef float f32x4 __attribute__((ext_vector_type(4)));
typedef float f32x16 __attribute__((ext_vector_type(16)));
typedef short bf16x8 __attribute__((ext_vector_type(8)));
typedef short s16x4 __attribute__((ext_vector_type(4)));
constexpr size_t MiB = 1u << 20;
constexpr size_t WS_CTL = 512 * 1024, CTL_BYTES = 64 * 1024;
constexpr size_t WS_SS0 = 0, WS_SS1 = 64 * 1024, WS_SS2 = 128 * 1024, WS_SSM = 192 * 1024;
constexpr size_t WS_W1GU = 1 * MiB, WS_W1D = 12 * MiB, WS_W2GU = 18 * MiB, WS_W2D = 29 * MiB, WS_WIN = 35 * MiB, WS_WOUT = 38 * MiB, WS_WMKV = 40 * MiB;
constexpr size_t WS_XB = 41 * MiB, WS_ACT = 73 * MiB, WS_PROJ = 73 * MiB, WS_Y = 121 * MiB, WS_MEMB = 161 * MiB, WS_MKV = 165 * MiB, WS_END = 167 * MiB;
static_assert(WS_W1GU + (size_t)2 * DFF * DM * 2 <= WS_W1D && WS_W1D + (size_t)DM * DFF * 2 <= WS_W2GU && WS_W2GU + (size_t)2 * DFF * DM * 2 <= WS_W2D && WS_W2D + (size_t)DM * DFF * 2 <= WS_WIN, "ws map");
static_assert(WS_WIN + (size_t)INC * DM * 2 <= WS_WOUT && WS_WOUT + (size_t)DM * DM * 2 <= WS_WMKV && WS_WMKV + (size_t)512 * DM * 2 <= WS_XB, "ws map");
static_assert(WS_ACT + (size_t)M * DFF * 2 <= WS_MEMB && WS_PROJ + (size_t)M * INC * 2 <= WS_Y && WS_Y + (size_t)M * DM * 2 <= WS_MEMB, "ws map");
constexpr int LDS_BYTES = 147456, RING_BYTES = 131072;

typedef float f32x2_t __attribute__((ext_vector_type(2))); typedef __bf16 bf16x2_t __attribute__((ext_vector_type(2)));
__device__ __forceinline__ unsigned pk2(float lo, float hi) { f32x2_t v = {lo, hi}; bf16x2_t b = __builtin_convertvector(v, bf16x2_t); return __builtin_bit_cast(unsigned, b); }
__device__ __forceinline__ float bflo(unsigned w) { return __uint_as_float(w << 16); }
__device__ __forceinline__ float bfhi(unsigned w) { return __uint_as_float(w & 0xffff0000u); }
__device__ __forceinline__ float wave_sum(float v) {
    v += __builtin_bit_cast(float, __builtin_amdgcn_update_dpp(0, __builtin_bit_cast(int, v), 0xB1, 0xf, 0xf, true));
    v += __builtin_bit_cast(float, __builtin_amdgcn_update_dpp(0, __builtin_bit_cast(int, v), 0x4E, 0xf, 0xf, true));
    v += __builtin_bit_cast(float, __builtin_amdgcn_update_dpp(0, __builtin_bit_cast(int, v), 0x141, 0xf, 0xf, true));
    v += __builtin_bit_cast(float, __builtin_amdgcn_update_dpp(0, __builtin_bit_cast(int, v), 0x140, 0xf, 0xf, true));
    v += __builtin_bit_cast(float, __builtin_amdgcn_update_dpp(0, __builtin_bit_cast(int, v), 0x142, 0xa, 0xf, true));
    v += __builtin_bit_cast(float, __builtin_amdgcn_update_dpp(0, __builtin_bit_cast(int, v), 0x143, 0xc, 0xf, true));
    return __builtin_bit_cast(float, __builtin_amdgcn_readlane(__builtin_bit_cast(int, v), 63));
}
__device__ __forceinline__ void transpose_item(const float* W, int K, int N, bf16* WT, int mode, const float* g, float scale, LAS float* scr, int item, int lane) {
    const int nblk = N / 64, kb = item / nblk, nb = item % nblk, k0 = 64 * kb, n0 = 64 * nb;
    const int kr = lane >> 4, n4 = (lane & 15) * 4;
    f32x4 v[16];
#pragma unroll
    for (int i = 0; i < 16; ++i) v[i] = __builtin_nontemporal_load((const f32x4*)(W + (size_t)(k0 + kr + 4 * i) * N + n0 + n4));
#pragma unroll
    for (int i = 0; i < 16; ++i) { const float gv = g ? g[k0 + kr + 4 * i] * scale : scale; LAS float* d = scr + (kr + 4 * i) * 65 + n4;
        d[0] = v[i].x * gv; d[1] = v[i].y * gv; d[2] = v[i].z * gv; d[3] = v[i].w * gv; }
    asm volatile("s_waitcnt lgkmcnt(0)" ::: "memory");
    const int rb = mode == 0 ? n0 : mode == 3 ? (n0 < 768 ? n0 : n0 < 1280 ? (1024 + 256 * (((n0 - 768) & 255) >> 7) + ((n0 - 768) >= 256 ? 128 : 0) + ((n0 - 768) & 127)) : n0 - 512) : (256 * (n0 >> 7) + (n0 & 127) + (mode == 2 ? 128 : 0));
    const int c = lane & 7;
#pragma unroll
    for (int j = 0; j < 8; ++j) { const int n = (lane >> 3) + 8 * j; const LAS float* s = scr + (8 * c) * 65 + n;
        u32x4 o; o.x = pk2(s[0 * 65], s[1 * 65]); o.y = pk2(s[2 * 65], s[3 * 65]); o.z = pk2(s[4 * 65], s[5 * 65]); o.w = pk2(s[6 * 65], s[7 * 65]);
        const int row = rb + n; *(u32x4*)(WT + (((size_t)(row >> 8) * (K >> 6) + (k0 >> 6)) * 256 + (row & 255)) * 64 + 8 * c) = o; }
    asm volatile("s_waitcnt lgkmcnt(0)" ::: "memory");
}
__device__ __forceinline__ void rows4_to_bf16_norm(const float* xrow, bf16* orow, int lane) {
    f32x4 v[4][4];
#pragma unroll
    for (int r = 0; r < 4; ++r)
#pragma unroll
        for (int j = 0; j < 4; ++j) v[r][j] = __builtin_nontemporal_load((const f32x4*)(xrow + (size_t)r * DM) + 64 * j + lane);
#pragma unroll
    for (int r = 0; r < 4; ++r) { float s = 0.f;
#pragma unroll
        for (int j = 0; j < 4; ++j) s += (v[r][j].x * v[r][j].x + v[r][j].y * v[r][j].y) + (v[r][j].z * v[r][j].z + v[r][j].w * v[r][j].w);
        const float rs = __builtin_amdgcn_rsqf(wave_sum(s) * (1.0f / 1024.0f) + 1e-6f);
        u32x2* o8 = (u32x2*)(orow + (size_t)r * DM) + lane;
#pragma unroll
        for (int j = 0; j < 4; ++j) { u32x2 w; w.x = pk2(v[r][j].x * rs, v[r][j].y * rs); w.y = pk2(v[r][j].z * rs, v[r][j].w * rs); o8[64 * j] = w; } }
}
namespace att {
constexpr int ROWB = 144, KOFF = 0, VOFF = 256 * ROWB;
constexpr float LOG2E = 1.4426950408889634f;
__device__ __forceinline__ int crow(int r, int h) { return (r & 3) + 8 * (r >> 2) + 4 * h; }
__device__ __forceinline__ void sincos_rev(float ang, float& s, float& c) {
    const float hi = ang * 0.15915493667125702f, lo = __builtin_fmaf(ang, 0.15915493667125702f, -hi) + ang * 6.4206382432985265e-09f;
    const float r = __builtin_amdgcn_fractf(hi) + lo; s = __builtin_amdgcn_sinf(r); c = __builtin_amdgcn_cosf(r);
}
__device__ __forceinline__ float inv_freq(int i) {
    return i == 0 ? 1.0f : i == 1 ? 0.19392274474868576f : i == 2 ? 0.03760603093086393f : i == 3 ? 0.007292664737217109f : i == 4 ? 0.001414213562373095f : i == 5 ? 0.0002742481756762073f : i == 6 ? 5.318295896944988e-05f : 1.031338537721246e-05f;
}
__device__ __forceinline__ void kv_issue(u32x4 (&kr)[4], u32x4 (&vr)[4], const bf16* Ksrc, const bf16* Vsrc, int ld, int row_lo, int tid) {
    const int key = tid >> 1, half = tid & 1;
#pragma unroll
    for (int c = 0; c < 4; ++c) { kr[c] = (u32x4){0u, 0u, 0u, 0u}; vr[c] = (u32x4){0u, 0u, 0u, 0u}; }
    if (key >= row_lo) {
        const u32x4* kp = (const u32x4*)(Ksrc + (long)key * ld + 32 * half); const u32x4* vp = (const u32x4*)(Vsrc + (long)key * ld + 32 * half);
#pragma unroll
        for (int c = 0; c < 4; ++c) { kr[c] = kp[c]; vr[c] = vp[c]; }
    }
}
template <bool ROPE> __device__ __forceinline__ void kv_finish(LAS unsigned char* lds, const u32x4 (&kr)[4], const u32x4 (&vr)[4], const float* gk, const float* gq, float p, int tid) {
    const int key = tid >> 1, half = tid & 1;
    f32x4 gkv[8], gqv[8];
#pragma unroll
    for (int c = 0; c < 8; ++c) { gkv[c] = *(const f32x4*)(gk + 32 * half + 4 * c); gqv[c] = *(const f32x4*)(gq + 32 * half + 4 * c); }
    LAS unsigned char* vdst = lds + VOFF + key * ROWB + 64 * half;
#pragma unroll
    for (int c = 0; c < 4; ++c) *(LAS u32x4*)(vdst + 16 * c) = vr[c];
    float f[32]; float ss = 0.f;
#pragma unroll
    for (int c = 0; c < 4; ++c)
#pragma unroll
        for (int w = 0; w < 4; ++w) { const unsigned x = kr[c][w]; f[8 * c + 2 * w] = bflo(x); f[8 * c + 2 * w + 1] = bfhi(x); }
#pragma unroll
    for (int i = 0; i < 32; ++i) ss += f[i] * f[i];
    ss += __shfl_xor(ss, 1);
    const float rs = __builtin_amdgcn_rsqf(ss * (1.0f / 64.0f) + 1e-6f);
#pragma unroll
    for (int i = 0; i < 32; ++i) { const float gkk = gkv[i >> 2][i & 3], gqq = gqv[i >> 2][i & 3]; f[i] *= rs * ((ROPE && i < 16) ? (half == 0 ? gkk : gkk * gqq) : gkk * gqq); }
    if (ROPE) {
        if (half == 0) {
#pragma unroll
            for (int i = 0; i < 8; ++i) { float s, c; sincos_rev(p * inv_freq(i), s, c); const float x1 = f[i], x2 = f[8 + i]; f[i] = x1 * c - x2 * s; f[8 + i] = x2 * c + x1 * s; }
        }
    }
    LAS unsigned char* kdst = lds + KOFF + key * ROWB + 64 * half;
#pragma unroll
    for (int c = 0; c < 4; ++c) { u32x4 w; w.x = pk2(f[8 * c], f[8 * c + 1]); w.y = pk2(f[8 * c + 2], f[8 * c + 3]); w.z = pk2(f[8 * c + 4], f[8 * c + 5]); w.w = pk2(f[8 * c + 6], f[8 * c + 7]); *(LAS u32x4*)(kdst + 16 * c) = w; }
}
__device__ __forceinline__ void q_issue(u32x4 (&raw)[4], const bf16* Qrow0, int ldq, int lane) {
    const int ql = lane & 31, h = lane >> 5;
#pragma unroll
    for (int ds = 0; ds < 4; ++ds) raw[ds] = *(const u32x4*)(Qrow0 + (long)ql * ldq + 16 * ds + 8 * h);
}
template <int NKT, bool SWA> __device__ __forceinline__ void attn_wave(LAS unsigned char* lds, const u32x4 (&raw)[4], const f32x4 (&g0)[2], float p_, float sink2, int t0, bool blk0, bf16* Orow0, int ldo, int lane) {
    const int ql = lane & 31, h = lane >> 5;
    float f[4][8]; float ss = 0.f;
#pragma unroll
    for (int ds = 0; ds < 4; ++ds)
#pragma unroll
        for (int w = 0; w < 4; ++w) { const unsigned x = raw[ds][w]; f[ds][2 * w] = bflo(x); f[ds][2 * w + 1] = bfhi(x); }
#pragma unroll
    for (int ds = 0; ds < 4; ++ds)
#pragma unroll
        for (int i = 0; i < 8; ++i) ss += f[ds][i] * f[ds][i];
    ss += __shfl_xor(ss, 32);
    const float rs = __builtin_amdgcn_rsqf(ss * (1.0f / 64.0f) + 1e-6f) * (0.125f * LOG2E);
#pragma unroll
    for (int ds = 0; ds < 4; ++ds)
#pragma unroll
        for (int i = 0; i < 8; ++i) f[ds][i] *= rs;
    if (SWA) {
#pragma unroll
        for (int i = 0; i < 8; ++i) f[0][i] *= g0[i >> 2][i & 3];
#pragma unroll
        for (int i = 0; i < 8; ++i) { float s, c; sincos_rev(p_ * inv_freq(i), s, c); const float other = __shfl_xor(f[0][i], 32); f[0][i] = f[0][i] * c + (h ? other : -other) * s; }
    }
    bf16x8 qf[4];
#pragma unroll
    for (int ds = 0; ds < 4; ++ds) { u32x4 w; w.x = pk2(f[ds][0], f[ds][1]); w.y = pk2(f[ds][2], f[ds][3]); w.z = pk2(f[ds][4], f[ds][5]); w.w = pk2(f[ds][6], f[ds][7]); qf[ds] = __builtin_bit_cast(bf16x8, w); }
    constexpr float SOFF = 8.0f;
    f32x16 p[NKT];
#pragma unroll
    for (int kt = 0; kt < NKT; ++kt) {
#pragma unroll
        for (int r = 0; r < 16; ++r) p[kt][r] = -SOFF;
        const LAS unsigned char* kb = lds + KOFF + (32 * (t0 + kt) + ql) * ROWB + 16 * h;
#pragma unroll
        for (int ds = 0; ds < 4; ++ds) { const bf16x8 a = *(const LAS bf16x8*)(kb + 32 * ds); p[kt] = __builtin_amdgcn_mfma_f32_32x32x16_bf16(a, qf[ds], p[kt], 0, 0, 0); }
    }
    const float NEG = -INFINITY;
    if (SWA) {
#pragma unroll
        for (int r = 0; r < 16; ++r) { const int kvl = crow(r, h); if (kvl <= ql) p[0][r] = NEG; if (kvl > ql) p[NKT - 1][r] = NEG; }
        if (blk0) {
#pragma unroll
            for (int kt = 0; kt < NKT; ++kt) if (t0 + kt < 4) {
#pragma unroll
                for (int r = 0; r < 16; ++r) p[kt][r] = NEG; }
        }
    }
    float l = 0.f;
#pragma unroll
    for (int kt = 0; kt < NKT; ++kt)
#pragma unroll
        for (int r = 0; r < 16; ++r) { p[kt][r] = __builtin_amdgcn_exp2f(p[kt][r]); l += p[kt][r]; }
    l += __shfl_xor(l, 32);
    if (SWA) l += __builtin_amdgcn_exp2f(sink2 - SOFF);
    const float inv = 1.0f / l;
    f32x16 o[2];
#pragma unroll
    for (int db = 0; db < 2; ++db)
#pragma unroll
        for (int r = 0; r < 16; ++r) o[db][r] = 0.f;
    const LAS unsigned char* vb = lds + VOFF + (4 * h + ((lane & 15) >> 2)) * ROWB + (16 * ((lane >> 4) & 1) + 4 * (lane & 3)) * 2;
#pragma unroll
    for (int kt = 0; kt < NKT; ++kt)
#pragma unroll
        for (int s = 0; s < 2; ++s) {
            u32x4 w; w.x = pk2(p[kt][8 * s], p[kt][8 * s + 1]); w.y = pk2(p[kt][8 * s + 2], p[kt][8 * s + 3]); w.z = pk2(p[kt][8 * s + 4], p[kt][8 * s + 5]); w.w = pk2(p[kt][8 * s + 6], p[kt][8 * s + 7]);
            const bf16x8 pf = __builtin_bit_cast(bf16x8, w);
            const LAS unsigned char* vp = vb + (32 * (t0 + kt) + 16 * s) * ROWB;
#pragma unroll
            for (int db = 0; db < 2; ++db) {
                const s16x4 lo = __builtin_bit_cast(s16x4, __builtin_amdgcn_ds_read_tr16_b64_v4i16((LAS s16x4*)(vp + 64 * db)));
                const s16x4 hi = __builtin_bit_cast(s16x4, __builtin_amdgcn_ds_read_tr16_b64_v4i16((LAS s16x4*)(vp + 64 * db + 8 * ROWB)));
                const bf16x8 a = (bf16x8){lo[0], lo[1], lo[2], lo[3], hi[0], hi[1], hi[2], hi[3]};
                o[db] = __builtin_amdgcn_mfma_f32_32x32x16_bf16(a, pf, o[db], 0, 0, 0);
            }
        }
    bf16* orow = Orow0 + (long)ql * ldo;
#pragma unroll
    for (int db = 0; db < 2; ++db)
#pragma unroll
        for (int g = 0; g < 4; ++g) { u32x2 w; w.x = pk2(o[db][4 * g] * inv, o[db][4 * g + 1] * inv); w.y = pk2(o[db][4 * g + 2] * inv, o[db][4 * g + 3] * inv);
            *(u32x2*)(orow + 32 * db + 8 * g + 4 * h) = w; }
}
}

__device__ __forceinline__ void conv_unit(LAS unsigned char* lds, const bf16* proj, int b, int tt, const float* w_dw, const float* b_dw, const float* g_ln, const float* b_ln, bf16* y, int tid) {
    LAS float* H = (LAS float*)lds;
    const int t0 = tt * 64;
    {
        u32x4 av[6];
#pragma unroll
        for (int k = 0; k < 6; ++k) {
            const int idx = tid + k * NTHR, tk = idx >> 5, ch = idx & 31, t = t0 - 30 + tk;
            av[k] = (u32x4){0u, 0u, 0u, 0u};
            if (idx < 94 * 32 && t >= 0) av[k] = *(const u32x4*)(proj + (size_t)(b * SEQ + t) * INC + 1024 + ch * 8);
        }
#pragma unroll
        for (int k = 0; k < 6; ++k) {
            const int idx = tid + k * NTHR, tk = idx >> 5, ch = idx & 31;
            if (idx < 94 * 32) { *(LAS f32x4*)(H + tk * 256 + ch * 8) = (f32x4){bflo(av[k][0]), bfhi(av[k][0]), bflo(av[k][1]), bfhi(av[k][1])};
                                 *(LAS f32x4*)(H + tk * 256 + ch * 8 + 4) = (f32x4){bflo(av[k][2]), bfhi(av[k][2]), bflo(av[k][3]), bfhi(av[k][3])}; }
        }
    }
    __syncthreads();
    {
        const int cp = tid & 127, tg = tid >> 7;
        f32x2_t w2[31];
#pragma unroll
        for (int j = 0; j < 31; ++j) w2[j] = *(const f32x2_t*)(w_dw + j * 256 + 2 * cp);
        const f32x2_t bias2 = *(const f32x2_t*)(b_dw + 2 * cp);
        f32x2_t outv[16];
#pragma unroll
        for (int ck = 0; ck < 2; ++ck) {
            f32x2_t hv[38];
#pragma unroll
            for (int i = 0; i < 38; ++i) hv[i] = *(const LAS f32x2_t*)(H + (tg * 16 + ck * 8 + i) * 256 + 2 * cp);
#pragma unroll
            for (int k = 0; k < 8; ++k) { f32x2_t acc2 = bias2;
#pragma unroll
                for (int j = 0; j < 31; ++j) acc2 = __builtin_elementwise_fma(w2[j], hv[k + j], acc2);
                outv[ck * 8 + k] = acc2; }
        }
        __syncthreads();
#pragma unroll
        for (int k = 0; k < 16; ++k) *(LAS f32x2_t*)(H + (tg * 16 + k) * 256 + 2 * cp) = outv[k];
        __syncthreads();
    }
    const int wv = tid >> 6, lane = tid & 63;
    const f32x4 gg = *(const f32x4*)(g_ln + 4 * lane), bb = *(const f32x4*)(b_ln + 4 * lane);
#pragma unroll
    for (int k = 0; k < 8; ++k) {
        const int tok = wv * 8 + k; f32x4 v = *(LAS f32x4*)(H + tok * 256 + 4 * lane);
        const float mean = wave_sum((v.x + v.y) + (v.z + v.w)) * (1.0f / 256.0f);
        v = v - mean;
        const float var = wave_sum((v.x * v.x + v.y * v.y) + (v.z * v.z + v.w * v.w)) * (1.0f / 256.0f);
        const float rs = __builtin_amdgcn_rsqf(var + 1e-6f);
        v = v * rs * gg + bb;
        float o[4];
#pragma unroll
        for (int i = 0; i < 4; ++i) o[i] = v[i] * __builtin_amdgcn_rcpf(1.0f + __builtin_amdgcn_exp2f(-1.4426950408889634f * v[i]));
        u32x2 pw; pw.x = pk2(o[0], o[1]); pw.y = pk2(o[2], o[3]);
        *(u32x2*)(y + (size_t)(b * SEQ + t0 + tok) * DM + 512 + 4 * lane) = pw;
    }
    __syncthreads();
}

#define XB_TMO      128
#define XB_XCNT(j)  (256  + 64 * (j))
#define XB_XSUB(j)  (1280 + 64 * (j))
#define XB_XGEN(j)  (2304 + 64 * (j))
#define XB_TOP      3328
#define XB_TOPGEN   3392
#define XCD_BAR_WORDS 3456
#define XB_SPIN_CAP (1u << 18)

__device__ __forceinline__ unsigned xb_ld(unsigned* p)              { return __hip_atomic_load(p, __ATOMIC_RELAXED, __HIP_MEMORY_SCOPE_AGENT); }
__device__ __forceinline__ unsigned xb_add(unsigned* p, unsigned v) { return __hip_atomic_fetch_add(p, v, __ATOMIC_RELAXED, __HIP_MEMORY_SCOPE_AGENT); }
__device__ __forceinline__ unsigned xb_xcc_id() { return (unsigned)__builtin_amdgcn_s_getreg((3 << 11) | 20) & 0xFu; }
#define XB_SPIN(cond, bar) do { unsigned _sp = 0; while (cond) { __builtin_amdgcn_s_sleep(1); \
    if ((++_sp & 255u) == 0u) { if (xb_ld(&(bar)[XB_TMO])) break; if (_sp > XB_SPIN_CAP) { atomicAdd(&(bar)[XB_TMO], 1u); break; } } } } while (0)

struct XcdBarrier {
    unsigned* bar; unsigned x;
    volatile LAS unsigned* st;
};

__device__ __forceinline__ XcdBarrier xcd_barrier_post(unsigned* bar, volatile LAS unsigned* st) {
    XcdBarrier b; b.bar = bar; b.x = xb_xcc_id(); b.st = st;
    if (threadIdx.x == 0) (void)xb_add(&bar[XB_XCNT(b.x)], 1u);
    return b;
}
__device__ __forceinline__ void xcd_barrier_complete(unsigned* bar, unsigned x, unsigned& nloc, unsigned& nx) {
    const unsigned G = gridDim.x * gridDim.y * gridDim.z;
    unsigned sum, cnt, mine, sp = 0u;
    for (;;) {
        sum = 0u; cnt = 0u; mine = 0u;
#pragma unroll
        for (unsigned j = 0; j < 16; ++j) { const unsigned c = xb_ld(&bar[XB_XCNT(j)]); sum += c; cnt += (c > 0u) ? 1u : 0u; mine = (j == x) ? c : mine; }
        if (sum == G) break;
        __builtin_amdgcn_s_sleep(1);
        if ((++sp & 255u) == 0u) { if (xb_ld(&bar[XB_TMO])) break; if (sp > XB_SPIN_CAP) { atomicAdd(&bar[XB_TMO], 1u); break; } }
    }
    nloc = mine > 0u ? mine : 1u; nx = cnt > 0u ? cnt : 1u;
}

__device__ __forceinline__ void xcd_barrier(const XcdBarrier& b) {
    asm volatile("s_waitcnt vmcnt(0)" ::: "memory");
    __syncthreads();
    if (threadIdx.x == 0) {
        unsigned* bar = b.bar;
        __builtin_amdgcn_s_waitcnt(0);
        unsigned nloc = b.st[0], nx = b.st[1];
        if (nloc == 0u) { xcd_barrier_complete(bar, b.x, nloc, nx); b.st[0] = nloc; b.st[1] = nx; }
        const unsigned old = xb_add(&bar[XB_XSUB(b.x)], 1u);
        const unsigned gen = old / nloc;
        if (old + 1u == (gen + 1u) * nloc) {
            __builtin_amdgcn_fence(__ATOMIC_RELEASE, "agent");
            asm volatile("s_waitcnt vmcnt(0)" ::: "memory");
            const unsigned og = xb_add(&bar[XB_TOP], 1u);
            const unsigned tg = og / nx;
            if (og + 1u == (tg + 1u) * nx) xb_add(&bar[XB_TOPGEN], 1u);
            else XB_SPIN(xb_ld(&bar[XB_TOPGEN]) == tg, bar);
            __builtin_amdgcn_fence(__ATOMIC_ACQUIRE, "agent");
            xb_add(&bar[XB_XGEN(b.x)], 1u);
            asm volatile("s_waitcnt vmcnt(0)" ::: "memory");
        } else {
            asm volatile("buffer_inv sc1" ::: "memory");
            XB_SPIN(xb_ld(&bar[XB_XGEN(b.x)]) == gen, bar);
            asm volatile("s_waitcnt vmcnt(0)" ::: "memory");
        }
    }
    __syncthreads();
}

struct Args { const float* in[25]; float* out; unsigned char* ws; int ph_lo, ph_hi, li, pad; };
constexpr int NPHASE = 9;
__global__ void __launch_bounds__(NTHR, 2) fwd_kernel(Args a) {
    extern __shared__ __attribute__((aligned(16))) unsigned char lds_raw[];
    LAS unsigned char* lds = (LAS unsigned char*)lds_raw;
    cg::grid_group grid = cg::this_grid();
    const int tid = threadIdx.x, lane = tid & 63, wave = __builtin_amdgcn_readfirstlane(tid >> 6);
    const int G = gridDim.x, bx = blockIdx.x;
    unsigned char* ws = a.ws;
    const float* x = a.in[0]; const float* mem = a.in[1]; const int* positions = (const int*)a.in[2];
    float* ss0 = (float*)(ws + WS_SS0); float* ss1 = (float*)(ws + WS_SS1); float* ss2 = (float*)(ws + WS_SS2); float* ssm = (float*)(ws + WS_SSM);
    bf16* W1GU = (bf16*)(ws + WS_W1GU); bf16* W1D = (bf16*)(ws + WS_W1D); bf16* W2GU = (bf16*)(ws + WS_W2GU); bf16* W2D = (bf16*)(ws + WS_W2D);
    bf16* WIN = (bf16*)(ws + WS_WIN); bf16* WOUT = (bf16*)(ws + WS_WOUT); bf16* WMKV = (bf16*)(ws + WS_WMKV);
    bf16* XB = (bf16*)(ws + WS_XB); bf16* ACT = (bf16*)(ws + WS_ACT); bf16* PROJ = (bf16*)(ws + WS_PROJ); bf16* Y = (bf16*)(ws + WS_Y);
    bf16* MEMB = (bf16*)(ws + WS_MEMB); bf16* MKV = (bf16*)(ws + WS_MKV);
    const int lo = a.ph_lo, hi = a.ph_hi;
#define IN(k) (lo <= (k) && (k) < hi)
    volatile LAS unsigned* MISC = (volatile LAS unsigned*)(lds + LDS_BYTES - 128);
    if (tid < 32) MISC[tid] = 0u;
    __syncthreads();
    const XcdBarrier bar = xcd_barrier_post((unsigned*)(ws + WS_CTL) + a.li * XCD_BAR_WORDS, MISC + 8);
    if (a.ph_lo < 0) grid.sync();
#define SEAM(k) do { if (IN(k) && IN((k) + 1)) xcd_barrier(bar); } while (0)

    if (IN(0)) {
        LAS float* scr = (LAS float*)(lds + wave * 16640);
        const int gw = bx * NWAVES + wave, NGW = G * NWAVES;
        constexpr int I_GU = (DM / 64) * (DFF / 64), I_D = (DFF / 64) * (DM / 64), I_IN = (DM / 64) * (INC / 64), I_OUT = (DM / 64) * (DM / 64), I_MKV = (DM / 64) * (512 / 64);
        constexpr int NITEMS = 2 * I_GU + I_MKV, NXG = M / 4, NMG = MROWS / 4;
        for (int it = gw; it < NITEMS + NXG + NMG; it += NGW) {
            int r = it;
            if (r < I_GU) { transpose_item(a.in[4], DM, DFF, W1GU, 1, a.in[3], 1.f, scr, r, lane); continue; } r -= I_GU;
            if (r < I_GU) { transpose_item(a.in[5], DM, DFF, W1GU, 2, a.in[3], 1.f, scr, r, lane); continue; } r -= I_GU;
            if (r < I_MKV) { transpose_item(a.in[17], DM, 512, WMKV, 0, a.in[16], 1.f, scr, r, lane); continue; } r -= I_MKV;
            if (r < NXG) { rows4_to_bf16_norm(x + (size_t)r * 4 * DM, XB + (size_t)r * 4 * DM, lane); continue; } r -= NXG;
            rows4_to_bf16_norm(mem + (size_t)r * 4 * DM, MEMB + (size_t)r * 4 * DM, lane);
        }
        for (int i = bx * NTHR + tid; i < M; i += G * NTHR) ss2[i] = 0.f;
        __syncthreads();
    }
    SEAM(0);
    if (IN(1)) {
        for (int i = bx * NTHR + tid; i < M; i += G * NTHR) ss1[i] = 0.f;
        { pg8::Gemm g{XB, W1GU, M, 2 * DFF, DM, 2 * DM, 128, 128, 32768}; pg8::StaticOrder S; S.init(M, 2 * DFF, G, bx); pg8::EpiSwiGLU<false> E{ACT, DFF, nullptr};
          pg8::gemm_phase<pg8::EpiSwiGLU<false>, pg8::StaticOrder, true, true>(lds, g, S, E); }
        { pg8::Gemm g{MEMB, WMKV, MROWS, 512, DM, 2 * DM, 128, 128, 32768}; pg8::ExtraOrder S{bx, G >= 160 ? 128 : 0, 2, 16}; pg8::EpiScaleBf16<false> E{MKV, 512, nullptr};
          pg8::gemm_phase<pg8::EpiScaleBf16<false>, pg8::ExtraOrder, true, true>(lds, g, S, E); }
        {
            const int c0 = G >= 160 ? 144 : 0;
            if (bx >= c0) {
                LAS float* scr = (LAS float*)(lds + wave * 16640);
                constexpr int I_GU = (DM / 64) * (DFF / 64), I_D = (DFF / 64) * (DM / 64), I_IN = (DM / 64) * (INC / 64), I_OUT = (DM / 64) * (DM / 64);
                for (int it = (bx - c0) * NWAVES + wave; it < 2 * I_GU + 2 * I_D + I_IN + I_OUT; it += (G - c0) * NWAVES) {
                    int r = it;
                    if (r < I_D) { transpose_item(a.in[6], DFF, DM, W1D, 0, nullptr, 0.5f, scr, r, lane); continue; } r -= I_D;
                    if (r < I_IN) { transpose_item(a.in[8], DM, INC, WIN, 3, a.in[7], 1.f, scr, r, lane); continue; } r -= I_IN;
                    if (r < I_OUT) { transpose_item(a.in[20], DM, DM, WOUT, 0, nullptr, 1.f, scr, r, lane); continue; } r -= I_OUT;
                    if (r < I_GU) { transpose_item(a.in[22], DM, DFF, W2GU, 1, a.in[21], 1.f, scr, r, lane); continue; } r -= I_GU;
                    if (r < I_GU) { transpose_item(a.in[23], DM, DFF, W2GU, 2, a.in[21], 1.f, scr, r, lane); continue; } r -= I_GU;
                    transpose_item(a.in[24], DFF, DM, W2D, 0, nullptr, 0.5f, scr, r, lane);
                }
            }
        }
    }
    SEAM(1);
    if (IN(2)) {
        pg8::Gemm g{ACT, W1D, M, DM, DFF, 128, 32768, 128, 32768}; pg8::StaticOrder S; S.init(M, DM, G, bx); pg8::EpiResid<0> E{x, nullptr, XB, ss1};
        pg8::gemm_phase<pg8::EpiResid<0>, pg8::StaticOrder, true, true>(lds, g, S, E);
    }
    SEAM(2);
    if (IN(3)) {
        pg8::Gemm g{XB, WIN, M, 1024, DM, 2 * DM, 128, 128, 32768}; pg8::StaticOrder S; S.init(M, 1024, G, bx); pg8::EpiScaleBf16<true> E{PROJ, INC, ss1};
        pg8::gemm_phase<pg8::EpiScaleBf16<true>, pg8::StaticOrder, true, true>(lds, g, S, E);
    }
    SEAM(3);
#define SWA_UNIT(u_) do { const int u = (u_); const int b = u >> 5, g = (u >> 4) & 1, n = u & 15; \
            const long krow0 = (long)b * SEQ + (n - 1) * 128; const int hq = g * 4 + (wave >> 1); const long qrow = (long)b * SEQ + n * 128 + 64 * (wave & 1); \
            u32x4 kr[4], vr[4], raw0[4], raw1[4]; \
            att::kv_issue(kr, vr, PROJ + krow0 * INC + 512 + g * 64, PROJ + krow0 * INC + 640 + g * 64, INC, n == 0 ? 128 : 0, tid); \
            att::q_issue(raw0, PROJ + qrow * INC + hq * 64, INC, lane); att::q_issue(raw1, PROJ + (qrow + 32) * INC + hq * 64, INC, lane); \
            const int kpos = ((tid >> 1) >= (n == 0 ? 128 : 0)) ? positions[krow0 + (tid >> 1)] : 0; const int qp0 = positions[qrow + (lane & 31)], qp1 = positions[qrow + 32 + (lane & 31)]; \
            f32x4 g0[2]; g0[0] = *(const f32x4*)(a.in[9] + 8 * (lane >> 5)); g0[1] = *(const f32x4*)(a.in[9] + 8 * (lane >> 5) + 4); \
            const float sink2 = a.in[11][hq] * att::LOG2E; \
            att::kv_finish<true>(lds, kr, vr, a.in[10], a.in[9], (float)kpos, tid); \
            __syncthreads(); \
            att::attn_wave<5, true>(lds, raw0, g0, (float)qp0, sink2, 2 * (wave & 1), n == 0, Y + qrow * DM + hq * 64, DM, lane); \
            att::attn_wave<5, true>(lds, raw1, g0, (float)qp1, sink2, 2 * (wave & 1) + 1, n == 0, Y + (qrow + 32) * DM + hq * 64, DM, lane); \
            __syncthreads(); } while (0)
#define MEM_UNIT(u_) do { const int u = (u_); const int b = u >> 5, hm = (u >> 3) & 3, qt = u & 7; \
            const long qrow = (long)b * SEQ + qt * 256 + 32 * wave; \
            u32x4 kr[4], vr[4], raw0[4]; \
            att::kv_issue(kr, vr, MKV + (long)b * MEML * 512 + hm * 64, MKV + (long)b * MEML * 512 + 256 + hm * 64, 512, 0, tid); \
            att::q_issue(raw0, PROJ + qrow * INC + 768 + hm * 64, INC, lane); \
            f32x4 g0[2]; g0[0] = (f32x4){1.f, 1.f, 1.f, 1.f}; g0[1] = g0[0]; \
            att::kv_finish<false>(lds, kr, vr, a.in[19], a.in[18], 0.f, tid); \
            __syncthreads(); \
            att::attn_wave<8, false>(lds, raw0, g0, 0.f, 0.f, 0, false, Y + qrow * DM + 768 + hm * 64, DM, lane); \
            __syncthreads(); } while (0)
    if (IN(4)) {
        { pg8::Gemm g{XB, WIN + (size_t)1024 * DM, M, 512, DM, 2 * DM, 128, 128, 32768}; pg8::StaticOrder S; S.init(M, 512, G, bx); pg8::EpiGLU E{PROJ + 1024, INC, ss1};
          pg8::gemm_phase<pg8::EpiGLU, pg8::StaticOrder, true, true>(lds, g, S, E); }
        if (G == 256) {
            if (bx < 128) { MEM_UNIT(128 + bx); }
            else { SWA_UNIT(bx - 128); SWA_UNIT(bx); MEM_UNIT(bx - 128); }
        } else {
#pragma unroll 1
            for (int u = bx; u < 256; u += G) SWA_UNIT(u);
#pragma unroll 1
            for (int u = bx; u < 256; u += G) MEM_UNIT(u);
        }
    }
    SEAM(4);
    if (IN(5)) {
#pragma unroll 1
        for (int u = bx; u < 256; u += G) conv_unit(lds, PROJ, u >> 5, u & 31, a.in[12], a.in[13], a.in[14], a.in[15], Y, tid);
    }
    SEAM(5);
    if (IN(6)) {
        pg8::Gemm g{Y, WOUT, M, DM, DM, 2 * DM, 128, 128, 32768}; pg8::StaticOrder S; S.init(M, DM, G, bx); pg8::EpiResid<1> E{nullptr, nullptr, XB, ss2};
        pg8::gemm_phase<pg8::EpiResid<1>, pg8::StaticOrder, true, true>(lds, g, S, E);
    }
    SEAM(6);
    if (IN(7)) {
        pg8::Gemm g{XB, W2GU, M, 2 * DFF, DM, 2 * DM, 128, 128, 32768}; pg8::StaticOrder S; S.init(M, 2 * DFF, G, bx); pg8::EpiSwiGLU<true> E{ACT, DFF, ss2};
        pg8::gemm_phase<pg8::EpiSwiGLU<true>, pg8::StaticOrder, true, true>(lds, g, S, E);
    }
    SEAM(7);
    if (IN(8)) {
        pg8::Gemm g{ACT, W2D, M, DM, DFF, 128, 32768, 128, 32768}; pg8::StaticOrder S; S.init(M, DM, G, bx); pg8::EpiResid<2> E{nullptr, a.out, XB, nullptr};
        pg8::gemm_phase<pg8::EpiResid<2>, pg8::StaticOrder, true, true>(lds, g, S, E);
    }
#undef IN
#undef SEAM
}

extern "C" void kernel_launch(void* const* d_in, const int* in_sizes, int n_in, void* d_out, int out_size, void* d_ws, size_t ws_size, hipStream_t stream) {
    static int grid = 0;
    if (grid == 0) {
        int dev = 0, cus = 0, per_cu = 0;
        if (n_in != 25 || out_size != M * DM || ws_size < WS_END) { fprintf(stderr, "kernel_launch: unexpected shapes (n_in %d out %d ws %zu)\n", n_in, out_size, ws_size); grid = -1; return; }
        (void)hipGetDevice(&dev); (void)hipDeviceGetAttribute(&cus, hipDeviceAttributeMultiprocessorCount, dev);
        (void)hipFuncSetAttribute((const void*)fwd_kernel, hipFuncAttributeMaxDynamicSharedMemorySize, LDS_BYTES);
        (void)hipOccupancyMaxActiveBlocksPerMultiprocessor(&per_cu, (const void*)fwd_kernel, NTHR, LDS_BYTES);
        if (per_cu < 1) { fprintf(stderr, "kernel_launch: occupancy query says %d blocks per CU\n", per_cu); per_cu = 1; }
        (void)hipGetLastError();
        grid = cus;
    }
    if (grid < 0) return;
    if (hipMemsetAsync((char*)d_ws + WS_CTL, 0, CTL_BYTES, stream) != hipSuccess) { fprintf(stderr, "kernel_launch: memset failed\n"); return; }
    Args a{};
    for (int i = 0; i < 25; ++i) a.in[i] = (const float*)d_in[i];
    a.out = (float*)d_out; a.ws = (unsigned char*)d_ws;
    a.ph_lo = 0; a.ph_hi = NPHASE; a.li = 0;
    {
        void* args[] = {&a};
        hipError_t e = hipLaunchCooperativeKernel((const void*)fwd_kernel, dim3(grid), dim3(NTHR), args, LDS_BYTES, stream);
        if (e != hipSuccess) { fprintf(stderr, "kernel_launch: cooperative launch failed: %s (grid %d)\n", hipGetErrorString(e), grid); }
    }
}
```

```cpp
#include <hip/hip_runtime.h>
#include <hip/hip_cooperative_groups.h>
#include <cstdio>
#include <cstdint>
namespace cg = cooperative_groups;
namespace pg8 {
#define PG8_LAS __attribute__((address_space(3)))
typedef unsigned short bf16_t;
typedef short bf16x8 __attribute__((ext_vector_type(8)));
typedef float f32x4 __attribute__((ext_vector_type(4)));
typedef unsigned u32x4 __attribute__((ext_vector_type(4)));
constexpr int BM = 256, BK = 64, HALF = 128, HTB = HALF * BK * 2  , STAGE_BYTES = 8 * HTB, NXCD = 8, WGM = 8;

__host__ __device__ __forceinline__ int lds_byte(int r, int c) { const int st = (r >> 4) * 2 + (c >> 5), rr = r & 15, cc = c & 31, ob = rr * 64 + cc * 2; return st * 1024 + (ob ^ (((ob >> 9) & 1) << 5)); }
__host__ __device__ __forceinline__ void stage_rc(int b, int& R, int& C) { const int st = b / 1024, sb = b % 1024, swz = sb ^ (((sb >> 9) & 1) << 5); R = (st >> 1) * 16 + swz / 64; C = (st & 1) * 32 + (swz % 64) / 2; }
__host__ __device__ __forceinline__ int perm32(int rho) { const int n = rho >> 4, i = rho & 15; return 8 * (i >> 2) + 4 * n + (i & 3); }

struct Unit { int pm, pn; };
struct Gemm { const bf16_t* A; const bf16_t* Bt; int M, N, K; int apitch, akstep, bpitch, bkstep; };

struct StaticOrder {
    int nM, nN, nwg, G, c;
    __host__ __device__ void init(int M, int N, int G_, int c_) { nM = M / BM; nN = N / BM; nwg = nM * nN; G = G_; c = c_; }
    __host__ __device__ bool next(int i, Unit& u) const {
        const long L = (long)i * G + c; if (L >= nwg) return false;
        int wgid = (int)L; { const int q = nwg / NXCD, r = nwg % NXCD, xcd = wgid % NXCD, off = wgid / NXCD; wgid = (xcd < r ? xcd * (q + 1) : r * (q + 1) + (xcd - r) * q) + off; }
        const int nig = WGM * nN, gid = wgid / nig, fm = gid * WGM, gsz = (nM - fm) < WGM ? (nM - fm) : WGM;
        u.pm = fm + ((wgid % nig) % gsz); u.pn = (wgid % nig) / gsz; return true;
    }
    __device__ __forceinline__ void a_ready(const Unit&) const {}
    __device__ __forceinline__ void done(const Unit&) const {}
};

__device__ __forceinline__ unsigned cvt_pk_bf16(float lo, float hi) { unsigned r; asm volatile("v_cvt_pk_bf16_f32 %0, %1, %2" : "=v"(r) : "v"(lo), "v"(hi)); return r; }
__device__ __forceinline__ void st16_wt(const void* base, unsigned off, u32x4 v) {
    __amdgpu_buffer_rsrc_t r = __builtin_amdgcn_make_buffer_rsrc(const_cast<void*>(base), 0, 0x7fffffff, 0x00020000);
    __builtin_amdgcn_raw_buffer_store_b128(v, r, (int)off, 0, 16);
}
__device__ __forceinline__ void st16_wt(const void* base, unsigned off, f32x4 v) { st16_wt(base, off, __builtin_bit_cast(u32x4, v)); }
typedef float f32x2 __attribute__((ext_vector_type(2)));
template <class Epi, class Sched, bool ALIGN_EPI = false, bool SP2 = false>
__device__ __forceinline__ void gemm_phase(PG8_LAS unsigned char* lds, const Gemm g, const Sched& S, const Epi& E) {
    const int tid = threadIdx.x, wid = __builtin_amdgcn_readfirstlane(tid >> 6), lane = tid & 63, wr = wid >> 2, wc = wid & 3, fr = lane & 15, fq = lane >> 4;
    const int K = g.K, nt = K / BK;
    unsigned voffA[2], voffB[2];
#pragma unroll
    for (int i = 0; i < 2; ++i) { int R, C; stage_rc(tid * 16 + i * 8192, R, C); const int Rb = Epi::PERM ? ((R & ~31) + perm32(R & 31)) : R;
        voffA[i] = (unsigned)(R * g.apitch + C * 2); voffB[i] = (unsigned)(Rb * g.bpitch + C * 2); }
    const size_t kstepA = (size_t)g.akstep, kstepB = (size_t)g.bkstep;
    const size_t hstepA = (size_t)HALF * g.apitch, hstepB = (size_t)HALF * g.bpitch;
    const size_t tstep = (size_t)BM * K * 2;
    const unsigned ldsw = (unsigned)wid * 1024u;
    const int aoff = lds_byte(wr * 64 + fr, fq * 8), boff = lds_byte(wc * 32 + fr, fq * 8);
#define PG8_SA(b, h) (((b) * 2 + (h)) * HTB)
#define PG8_SB(b, h) ((4 + (b) * 2 + (h)) * HTB)
#define PG8_STAGE(bufoff, gbase, voff) do { _Pragma("unroll") for (int _i = 0; _i < 2; ++_i) \
        __builtin_amdgcn_global_load_lds((const unsigned*)((const char*)(gbase) + (voff)[_i]), (PG8_LAS unsigned*)(lds + (bufoff) + ldsw + _i * 8192), 16, 0, 0); } while (0)
#define PG8_LDA(dst, b, h) do { _Pragma("unroll") for (int m = 0; m < 4; ++m) _Pragma("unroll") for (int k = 0; k < 2; ++k) dst[m][k] = *(const PG8_LAS bf16x8*)(lds + PG8_SA(b, h) + aoff + m * 2048 + k * 1024); } while (0)
#define PG8_LDB(dst, b, h) do { _Pragma("unroll") for (int n = 0; n < 2; ++n) _Pragma("unroll") for (int k = 0; k < 2; ++k) dst[n][k] = *(const PG8_LAS bf16x8*)(lds + PG8_SB(b, h) + boff + n * 2048 + k * 1024); } while (0)
#define PG8_MMA(ai, bj, At, Bt) do { __builtin_amdgcn_s_setprio(1); _Pragma("unroll") for (int m = 0; m < 4; ++m) _Pragma("unroll") for (int n = 0; n < 2; ++n) _Pragma("unroll") for (int k = 0; k < 2; ++k) \
        acc[ai][bj][m][n] = __builtin_amdgcn_mfma_f32_16x16x32_bf16(Bt[n][k], At[m][k], acc[ai][bj][m][n], 0, 0, 0); __builtin_amdgcn_s_setprio(0); } while (0)
#define PG8_WAIT_V(n) asm volatile("s_waitcnt vmcnt(" #n ")" ::: "memory")
#define PG8_WAIT_L(n) asm volatile("s_waitcnt lgkmcnt(" #n ")" ::: "memory")
#define PG8_BAR __builtin_amdgcn_s_barrier()
#define PG8_SCHED __builtin_amdgcn_sched_barrier(0)
    Unit cur, nxt; int ui = 0;
    if (!S.next(0, cur)) return;
    float epre[8]; E.prefetch(epre, cur, wr, fr);
    f32x4 acc[2][2][4][2];
#pragma unroll
    for (int a = 0; a < 2; ++a)
#pragma unroll
        for (int b = 0; b < 2; ++b)
#pragma unroll
            for (int m = 0; m < 4; ++m)
#pragma unroll
                for (int n = 0; n < 2; ++n) acc[a][b][m][n] = (f32x4){0.f, 0.f, 0.f, 0.f};
    bf16x8 At[4][2], B0[2][2], B1[2][2];
    const char* cA = (const char*)g.A + (size_t)cur.pm * tstep; const char* cB = (const char*)g.Bt + (size_t)cur.pn * tstep;
    S.a_ready(cur);
    if constexpr (SP2) {
        PG8_STAGE(PG8_SB(0, 0), cB, voffB); PG8_STAGE(PG8_SB(0, 1), cB + hstepB, voffB); PG8_STAGE(PG8_SA(0, 0), cA, voffA); PG8_STAGE(PG8_SA(0, 1), cA + hstepA, voffA);
        if (wr == 1) PG8_BAR;
        PG8_WAIT_V(2); PG8_BAR;
        PG8_STAGE(PG8_SB(1, 0), cB + kstepB, voffB); PG8_STAGE(PG8_SA(1, 0), cA + kstepA, voffA); PG8_STAGE(PG8_SB(1, 1), cB + hstepB + kstepB, voffB);
        PG8_WAIT_V(6); PG8_BAR;
    } else {
        PG8_STAGE(PG8_SB(0, 0), cB, voffB); PG8_STAGE(PG8_SA(0, 0), cA, voffA); PG8_STAGE(PG8_SB(0, 1), cB + hstepB, voffB); PG8_STAGE(PG8_SA(0, 1), cA + hstepA, voffA);
        if (wr == 1) PG8_BAR;
        PG8_WAIT_V(4); PG8_BAR;
        PG8_STAGE(PG8_SB(1, 0), cB + kstepB, voffB); PG8_STAGE(PG8_SA(1, 0), cA + kstepA, voffA); PG8_STAGE(PG8_SB(1, 1), cB + hstepB + kstepB, voffB);
        PG8_WAIT_V(6); PG8_BAR;
    }
    for (;;) {
        const bool has_next = S.next(ui + 1, nxt);
        const char* nA = has_next ? (const char*)g.A + (size_t)nxt.pm * tstep : cA; const char* nB = has_next ? (const char*)g.Bt + (size_t)nxt.pn * tstep : cB;
        for (int t = 0; t < nt; t += 2) {
            const bool last = (t == nt - 2);
            const char* a1 = cA + (size_t)(t + 1) * kstepA;
            const char* a2 = last ? nA : cA + (size_t)(t + 2) * kstepA; const char* b2 = last ? nB : cB + (size_t)(t + 2) * kstepB;
            const char* a3 = a2 + kstepA; const char* b3 = b2 + kstepB;
            if (last && has_next) S.a_ready(nxt);
            if constexpr (SP2) {
            PG8_LDB(B0, 0, 0); PG8_LDB(B1, 0, 1); PG8_SCHED; PG8_LDA(At, 0, 0); PG8_STAGE(PG8_SA(1, 1), a1 + hstepA, voffA);
            PG8_WAIT_V(8); PG8_WAIT_L(0); PG8_BAR; PG8_MMA(0, 0, At, B0); PG8_MMA(0, 1, At, B1); PG8_BAR; PG8_SCHED;
            PG8_LDA(At, 0, 1); PG8_STAGE(PG8_SB(0, 0), b2, voffB); PG8_STAGE(PG8_SB(0, 1), b2 + hstepB, voffB); PG8_STAGE(PG8_SA(0, 0), a2, voffA);
            PG8_WAIT_V(8); PG8_WAIT_L(0); PG8_BAR; PG8_MMA(1, 0, At, B0); PG8_MMA(1, 1, At, B1); PG8_BAR; PG8_SCHED;
            PG8_LDB(B0, 1, 0); PG8_LDB(B1, 1, 1); PG8_SCHED; PG8_LDA(At, 1, 0); PG8_STAGE(PG8_SA(0, 1), a2 + hstepA, voffA);
            PG8_WAIT_V(8); PG8_WAIT_L(0); PG8_BAR; PG8_MMA(0, 0, At, B0); PG8_MMA(0, 1, At, B1); PG8_BAR; PG8_SCHED;
            PG8_LDA(At, 1, 1); PG8_STAGE(PG8_SB(1, 0), b3, voffB); PG8_STAGE(PG8_SB(1, 1), b3 + hstepB, voffB); PG8_STAGE(PG8_SA(1, 0), a3, voffA);
            PG8_WAIT_V(8); PG8_WAIT_L(0); PG8_BAR; PG8_MMA(1, 0, At, B0); PG8_MMA(1, 1, At, B1); PG8_BAR; PG8_SCHED;
            } else {
            PG8_LDB(B0, 0, 0); PG8_SCHED; PG8_LDA(At, 0, 0); PG8_STAGE(PG8_SA(1, 1), a1 + hstepA, voffA);
            PG8_WAIT_L(8); PG8_BAR; PG8_WAIT_L(0); PG8_MMA(0, 0, At, B0); PG8_BAR; PG8_SCHED;
            PG8_LDB(B1, 0, 1); PG8_STAGE(PG8_SB(0, 0), b2, voffB);
            PG8_BAR; PG8_WAIT_L(0); PG8_MMA(0, 1, At, B1); PG8_BAR;
            PG8_LDA(At, 0, 1); PG8_STAGE(PG8_SA(0, 0), a2, voffA);
            PG8_BAR; PG8_WAIT_L(0); PG8_MMA(1, 0, At, B0); PG8_BAR; PG8_SCHED;
            PG8_STAGE(PG8_SB(0, 1), b2 + hstepB, voffB);
            PG8_WAIT_V(6); PG8_BAR; PG8_MMA(1, 1, At, B1); PG8_BAR;
            PG8_LDB(B0, 1, 0); PG8_SCHED; PG8_LDA(At, 1, 0); PG8_STAGE(PG8_SA(0, 1), a2 + hstepA, voffA);
            PG8_WAIT_L(8); PG8_BAR; PG8_WAIT_L(0); PG8_MMA(0, 0, At, B0); PG8_BAR; PG8_SCHED;
            PG8_LDB(B1, 1, 1); PG8_STAGE(PG8_SB(1, 0), b3, voffB);
            PG8_BAR; PG8_WAIT_L(0); PG8_MMA(0, 1, At, B1); PG8_BAR;
            PG8_LDA(At, 1, 1); PG8_STAGE(PG8_SA(1, 0), a3, voffA);
            PG8_BAR; PG8_WAIT_L(0); PG8_MMA(1, 0, At, B0); PG8_BAR; PG8_SCHED;
            PG8_STAGE(PG8_SB(1, 1), b3 + hstepB, voffB);
            PG8_WAIT_V(6); PG8_BAR; PG8_MMA(1, 1, At, B1); PG8_BAR;
            }
        }
        if constexpr (ALIGN_EPI) { if (wr == 0) PG8_BAR; }
        if constexpr (!Epi::AFTER_DRAIN) { E(acc, cur, wr, wc, fr, fq, epre); S.done(cur); if (has_next) E.prefetch(epre, nxt, wr, fr); }
        if (!has_next) break;
#pragma unroll
        for (int a = 0; a < 2; ++a)
#pragma unroll
            for (int b = 0; b < 2; ++b)
#pragma unroll
                for (int m = 0; m < 4; ++m)
#pragma unroll
                    for (int n = 0; n < 2; ++n) acc[a][b][m][n] = (f32x4){0.f, 0.f, 0.f, 0.f};
        cur = nxt; cA = nA; cB = nB; ++ui;
        if constexpr (ALIGN_EPI) { if (wr == 1) PG8_BAR; }
    }
    PG8_WAIT_V(0);
    if constexpr (!ALIGN_EPI) { if (wr == 0) PG8_BAR; }
    PG8_BAR;
    if constexpr (Epi::AFTER_DRAIN) { E.fused(acc, cur, wr, wc, fr, fq, lds, wid, lane); S.done(cur); }
#undef PG8_SA
#undef PG8_SB
#undef PG8_STAGE
#undef PG8_LDA
#undef PG8_LDB
#undef PG8_MMA
#undef PG8_WAIT_V
#undef PG8_WAIT_L
#undef PG8_BAR
#undef PG8_SCHED
}
}
namespace pg8 {
__device__ __forceinline__ float rstd_of(float ss) { return __builtin_amdgcn_rsqf(ss * (1.0f / 1024.0f) + 1e-6f); }
__device__ __forceinline__ float silu_mul(float g, float u) { return g * __builtin_amdgcn_rcpf(1.0f + __builtin_amdgcn_exp2f(-1.4426950408889634f * g)) * u; }
template <bool SS> struct EpiSwiGLU {
    static constexpr bool PERM = true, AFTER_DRAIN = false;
    bf16_t* O; int ldc; const float* ss;
    __device__ __forceinline__ void prefetch(float (&pre)[8], const Unit& u, int wr, int fr) const {
        const int row0 = u.pm * BM + wr * 64 + fr;
#pragma unroll
        for (int i = 0; i < 8; ++i) pre[i] = SS ? ss[row0 + (i >> 2) * HALF + (i & 3) * 16] : 1.f;
    }
    __device__ __forceinline__ void operator()(const f32x4 (&acc)[2][2][4][2], const Unit& u, int wr, int wc, int fr, int fq, const float (&pre)[8]) const {
        const int row0 = u.pm * BM + wr * 64 + fr, col0 = u.pn * HALF + wc * 32 + 8 * fq;
        float rsv[8];
#pragma unroll
        for (int i = 0; i < 8; ++i) rsv[i] = pre[i];
        if (SS) {
#pragma unroll
            for (int i = 0; i < 8; ++i) rsv[i] = rstd_of(rsv[i]); }
#pragma unroll
        for (int ai = 0; ai < 2; ++ai)
#pragma unroll
            for (int m = 0; m < 4; ++m) {
                const int row = row0 + ai * HALF + m * 16; const float rs = rsv[ai * 4 + m];
                typedef float f32x2 __attribute__((ext_vector_type(2)));
                u32x4 w;
#pragma unroll
                for (int n = 0; n < 2; ++n) {
                    const f32x4 gq = acc[ai][0][m][n], uq = acc[ai][1][m][n];
#pragma unroll
                    for (int hh = 0; hh < 2; ++hh) {
                        f32x2 g = (f32x2){gq[2 * hh], gq[2 * hh + 1]}, uu = (f32x2){uq[2 * hh], uq[2 * hh + 1]};
                        if (SS) { g = g * rs; uu = uu * rs; }
                        const f32x2 t = g * (-1.4426950408889634f);
                        f32x2 e; e.x = __builtin_amdgcn_exp2f(t.x); e.y = __builtin_amdgcn_exp2f(t.y);
                        const f32x2 d = e + 1.0f;
                        f32x2 r; r.x = __builtin_amdgcn_rcpf(d.x); r.y = __builtin_amdgcn_rcpf(d.y);
                        const f32x2 o = (g * uu) * r;
                        w[2 * n + hh] = cvt_pk_bf16(o.x, o.y);
                    }
                }
                st16_wt(O, (unsigned)((((size_t)u.pm * (ldc >> 6) + (col0 >> 6)) * 256 + (row & 255)) * 64 + (col0 & 63)) * 2u, w);
            }
    }
};
struct EpiGLU {
    static constexpr bool PERM = true, AFTER_DRAIN = false;
    bf16_t* O; int ldc; const float* ss;
    __device__ __forceinline__ void prefetch(float (&pre)[8], const Unit& u, int wr, int fr) const {
        const int row0 = u.pm * BM + wr * 64 + fr;
#pragma unroll
        for (int i = 0; i < 8; ++i) pre[i] = ss[row0 + (i >> 2) * HALF + (i & 3) * 16];
    }
    __device__ __forceinline__ void operator()(const f32x4 (&acc)[2][2][4][2], const Unit& u, int wr, int wc, int fr, int fq, const float (&pre)[8]) const {
        const int row0 = u.pm * BM + wr * 64 + fr, col0 = u.pn * HALF + wc * 32 + 8 * fq;
#pragma unroll
        for (int ai = 0; ai < 2; ++ai)
#pragma unroll
            for (int m = 0; m < 4; ++m) {
                const int row = row0 + ai * HALF + m * 16; const float rs = rstd_of(pre[ai * 4 + m]);
                u32x4 w;
#pragma unroll
                for (int n = 0; n < 2; ++n) {
                    const f32x4 aq = acc[ai][0][m][n], gq = acc[ai][1][m][n];
                    typedef float f32x2 __attribute__((ext_vector_type(2)));
#pragma unroll
                    for (int hh = 0; hh < 2; ++hh) {
                        const f32x2 av = (f32x2){aq[2 * hh], aq[2 * hh + 1]} * rs, gv = (f32x2){gq[2 * hh], gq[2 * hh + 1]} * (-1.4426950408889634f * rs);
                        f32x2 e; e.x = __builtin_amdgcn_exp2f(gv.x); e.y = __builtin_amdgcn_exp2f(gv.y);
                        const f32x2 d = e + 1.0f;
                        f32x2 r; r.x = __builtin_amdgcn_rcpf(d.x); r.y = __builtin_amdgcn_rcpf(d.y);
                        const f32x2 o = av * r;
                        w[2 * n + hh] = cvt_pk_bf16(o.x, o.y);
                    }
                }
                *(u32x4*)(O + (size_t)row * ldc + col0) = w;
            }
    }
};
template <bool SS> struct EpiScaleBf16 {
    static constexpr bool PERM = true, AFTER_DRAIN = false;
    bf16_t* O; int ldc; const float* ss;
    __device__ __forceinline__ void prefetch(float (&pre)[8], const Unit& u, int wr, int fr) const {
        const int row0 = u.pm * BM + wr * 64 + fr;
#pragma unroll
        for (int i = 0; i < 8; ++i) pre[i] = SS ? ss[row0 + (i >> 2) * HALF + (i & 3) * 16] : 1.f;
    }
    __device__ __forceinline__ void operator()(const f32x4 (&acc)[2][2][4][2], const Unit& u, int wr, int wc, int fr, int fq, const float (&pre)[8]) const {
        const int row0 = u.pm * BM + wr * 64 + fr, col0 = u.pn * BM + wc * 32 + 8 * fq;
        float rsv[8];
#pragma unroll
        for (int i = 0; i < 8; ++i) rsv[i] = pre[i];
        if (SS) {
#pragma unroll
            for (int i = 0; i < 8; ++i) rsv[i] = rstd_of(rsv[i]); }
#pragma unroll
        for (int ai = 0; ai < 2; ++ai)
#pragma unroll
            for (int m = 0; m < 4; ++m) {
                const int row = row0 + ai * HALF + m * 16; const float rs = rsv[ai * 4 + m];
#pragma unroll
                for (int bj = 0; bj < 2; ++bj) {
                    const f32x4 v0 = acc[ai][bj][m][0] * rs, v1 = acc[ai][bj][m][1] * rs; u32x4 w;
                    w.x = cvt_pk_bf16(v0[0], v0[1]); w.y = cvt_pk_bf16(v0[2], v0[3]); w.z = cvt_pk_bf16(v1[0], v1[1]); w.w = cvt_pk_bf16(v1[2], v1[3]);
                    st16_wt(O, (unsigned)((size_t)row * ldc + col0 + bj * HALF) * 2u, w);
                }
            }
    }
};
template <int MODE> struct EpiResid {
    static constexpr bool PERM = true, AFTER_DRAIN = false;
    const float* base; float* out; bf16_t* xb; float* ssn;
    __device__ __forceinline__ void prefetch(float (&)[8], const Unit&, int, int) const {}
    __device__ __forceinline__ void operator()(const f32x4 (&acc)[2][2][4][2], const Unit& u, int wr, int wc, int fr, int fq, const float (&)[8]) const {
        const int row0 = u.pm * BM + wr * 64 + fr, col0 = u.pn * BM + wc * 32 + 8 * fq;
        f32x4 pre[2][2][2]; u32x4 preb[2][2];
#define EPR_LOAD(slot, it) do { const size_t off_ = (size_t)(row0 + ((it) >> 2) * HALF + ((it) & 3) * 16) * 1024 + col0; \
        if (MODE == 0) { pre[slot][0][0] = __builtin_nontemporal_load((const f32x4*)(base + off_)); pre[slot][0][1] = __builtin_nontemporal_load((const f32x4*)(base + off_ + 4)); pre[slot][1][0] = __builtin_nontemporal_load((const f32x4*)(base + off_ + HALF)); pre[slot][1][1] = __builtin_nontemporal_load((const f32x4*)(base + off_ + HALF + 4)); } \
        else { preb[slot][0] = *(const u32x4*)(xb + off_); preb[slot][1] = *(const u32x4*)(xb + off_ + HALF); } } while (0)
        EPR_LOAD(0, 0); EPR_LOAD(1, 1);
        float sacc[8];
#pragma unroll
        for (int it = 0; it < 8; ++it) {
            const int ai = it >> 2, m = it & 3, row = row0 + ai * HALF + m * 16; float s = 0.f;
            f32x4 v[2][2];
#pragma unroll
            for (int bj = 0; bj < 2; ++bj) {
                f32x4 b0, b1;
                if (MODE == 0) { b0 = pre[it & 1][bj][0]; b1 = pre[it & 1][bj][1]; }
                else { const u32x4 w = preb[it & 1][bj]; b0 = (f32x4){__uint_as_float(w.x << 16), __uint_as_float(w.x & 0xffff0000u), __uint_as_float(w.y << 16), __uint_as_float(w.y & 0xffff0000u)};
                       b1 = (f32x4){__uint_as_float(w.z << 16), __uint_as_float(w.z & 0xffff0000u), __uint_as_float(w.w << 16), __uint_as_float(w.w & 0xffff0000u)}; }
                v[bj][0] = b0 + acc[ai][bj][m][0]; v[bj][1] = b1 + acc[ai][bj][m][1]; }
            if (it + 2 < 8) EPR_LOAD(it & 1, it + 2);
#pragma unroll
            for (int bj = 0; bj < 2; ++bj) {
                const size_t off = (size_t)row * 1024 + col0 + bj * HALF; const f32x4 v0 = v[bj][0], v1 = v[bj][1];
                if (MODE == 2) { *(f32x4*)(out + off) = v0; *(f32x4*)(out + off + 4) = v1; }
                else {
                    s += (v0[0] * v0[0] + v0[1] * v0[1]) + (v0[2] * v0[2] + v0[3] * v0[3]) + (v1[0] * v1[0] + v1[1] * v1[1]) + (v1[2] * v1[2] + v1[3] * v1[3]);
                    u32x4 w; w.x = cvt_pk_bf16(v0[0], v0[1]); w.y = cvt_pk_bf16(v0[2], v0[3]); w.z = cvt_pk_bf16(v1[0], v1[1]); w.w = cvt_pk_bf16(v1[2], v1[3]);
                    st16_wt(xb, (unsigned)off * 2u, w);
                }
            }
            sacc[it] = s;
        }
#undef EPR_LOAD
        if (MODE != 2) {
#pragma unroll
            for (int it = 0; it < 8; ++it) { float s = sacc[it]; s += __shfl_xor(s, 16); s += __shfl_xor(s, 32); if (fq == 0) unsafeAtomicAdd(ssn + row0 + (it >> 2) * HALF + (it & 3) * 16, s); }
        }
    }
};
struct ExtraOrder {
    int c, c0, nN, n;
    __device__ bool next(int i, Unit& u) const { const int k = c - c0; if (i > 0 || k < 0 || k >= n) return false; u.pm = k / nN; u.pn = k % nN; return true; }
    __device__ __forceinline__ void a_ready(const Unit&) const {}
    __device__ __forceinline__ void done(const Unit&) const {}
};
}

constexpr int BATCH = 8, SEQ = 2048, DM = 1024, M = BATCH * SEQ, DFF = 2816, INC = 1536, MEML = 256, MROWS = BATCH * MEML;
constexpr int NWAVES = 8, NTHR = 512;
#define LAS __attribute__((address_space(3)))
typedef unsigned short bf16;
typedef unsigned u32x4 __attribute__((ext_vector_type(4)));
typedef unsigned u32x2 __attribute__((ext_vector_type(2)));
typedef float f32x4 __attribute__((ext_vector_type(4)));
typedef float f32x16 __attribute__((ext_vector_type(16)));
typedef short bf16x8 __attribute__((ext_vector_type(8)));
typedef short s16x4 __attribute__((ext_vector_type(4)));
constexpr size_t MiB = 1u << 20;
constexpr size_t WS_CTL = 512 * 1024, CTL_BYTES = 64 * 1024;
constexpr size_t WS_SS0 = 0, WS_SS1 = 64 * 1024, WS_SS2 = 128 * 1024, WS_SSM = 192 * 1024;
constexpr size_t WS_W1GU = 1 * MiB, WS_W1D = 12 * MiB, WS_W2GU = 18 * MiB, WS_W2D = 29 * MiB, WS_WIN = 35 * MiB, WS_WOUT = 38 * MiB, WS_WMKV = 40 * MiB;
constexpr size_t WS_XB = 41 * MiB, WS_ACT = 73 * MiB, WS_PROJ = 73 * MiB, WS_Y = 121 * MiB, WS_MEMB = 161 * MiB, WS_MKV = 165 * MiB, WS_END = 167 * MiB;
static_assert(WS_W1GU + (size_t)2 * DFF * DM * 2 <= WS_W1D && WS_W1D + (size_t)DM * DFF * 2 <= WS_W2GU && WS_W2GU + (size_t)2 * DFF * DM * 2 <= WS_W2D && WS_W2D + (size_t)DM * DFF * 2 <= WS_WIN, "ws map");
static_assert(WS_WIN + (size_t)INC * DM * 2 <= WS_WOUT && WS_WOUT + (size_t)DM * DM * 2 <= WS_WMKV && WS_WMKV + (size_t)512 * DM * 2 <= WS_XB, "ws map");
static_assert(WS_ACT + (size_t)M * DFF * 2 <= WS_MEMB && WS_PROJ + (size_t)M * INC * 2 <= WS_Y && WS_Y + (size_t)M * DM * 2 <= WS_MEMB, "ws map");
constexpr int LDS_BYTES = 147456, RING_BYTES = 131072;

typedef float f32x2_t __attribute__((ext_vector_type(2))); typedef __bf16 bf16x2_t __attribute__((ext_vector_type(2)));
__device__ __forceinline__ unsigned pk2(float lo, float hi) { f32x2_t v = {lo, hi}; bf16x2_t b = __builtin_convertvector(v, bf16x2_t); return __builtin_bit_cast(unsigned, b); }
__device__ __forceinline__ float bflo(unsigned w) { return __uint_as_float(w << 16); }
__device__ __forceinline__ float bfhi(unsigned w) { return __uint_as_float(w & 0xffff0000u); }
__device__ __forceinline__ float wave_sum(float v) {
    v += __builtin_bit_cast(float, __builtin_amdgcn_update_dpp(0, __builtin_bit_cast(int, v), 0xB1, 0xf, 0xf, true));
    v += __builtin_bit_cast(float, __builtin_amdgcn_update_dpp(0, __builtin_bit_cast(int, v), 0x4E, 0xf, 0xf, true));
    v += __builtin_bit_cast(float, __builtin_amdgcn_update_dpp(0, __builtin_bit_cast(int, v), 0x141, 0xf, 0xf, true));
    v += __builtin_bit_cast(float, __builtin_amdgcn_update_dpp(0, __builtin_bit_cast(int, v), 0x140, 0xf, 0xf, true));
    v += __builtin_bit_cast(float, __builtin_amdgcn_update_dpp(0, __builtin_bit_cast(int, v), 0x142, 0xa, 0xf, true));
    v += __builtin_bit_cast(float, __builtin_amdgcn_update_dpp(0, __builtin_bit_cast(int, v), 0x143, 0xc, 0xf, true));
    return __builtin_bit_cast(float, __builtin_amdgcn_readlane(__builtin_bit_cast(int, v), 63));
}
__device__ __forceinline__ void transpose_item(const float* W, int K, int N, bf16* WT, int mode, const float* g, float scale, LAS float* scr, int item, int lane) {
    const int nblk = N / 64, kb = item / nblk, nb = item % nblk, k0 = 64 * kb, n0 = 64 * nb;
    const int kr = lane >> 4, n4 = (lane & 15) * 4;
    f32x4 v[16];
#pragma unroll
    for (int i = 0; i < 16; ++i) v[i] = __builtin_nontemporal_load((const f32x4*)(W + (size_t)(k0 + kr + 4 * i) * N + n0 + n4));
#pragma unroll
    for (int i = 0; i < 16; ++i) { const float gv = g ? g[k0 + kr + 4 * i] * scale : scale; LAS float* d = scr + (kr + 4 * i) * 65 + n4;
        d[0] = v[i].x * gv; d[1] = v[i].y * gv; d[2] = v[i].z * gv; d[3] = v[i].w * gv; }
    asm volatile("s_waitcnt lgkmcnt(0)" ::: "memory");
    const int rb = mode == 0 ? n0 : mode == 3 ? (n0 < 768 ? n0 : n0 < 1280 ? (1024 + 256 * (((n0 - 768) & 255) >> 7) + ((n0 - 768) >= 256 ? 128 : 0) + ((n0 - 768) & 127)) : n0 - 512) : (256 * (n0 >> 7) + (n0 & 127) + (mode == 2 ? 128 : 0));
    const int c = lane & 7;
#pragma unroll
    for (int j = 0; j < 8; ++j) { const int n = (lane >> 3) + 8 * j; const LAS float* s = scr + (8 * c) * 65 + n;
        u32x4 o; o.x = pk2(s[0 * 65], s[1 * 65]); o.y = pk2(s[2 * 65], s[3 * 65]); o.z = pk2(s[4 * 65], s[5 * 65]); o.w = pk2(s[6 * 65], s[7 * 65]);
        const int row = rb + n; *(u32x4*)(WT + (((size_t)(row >> 8) * (K >> 6) + (k0 >> 6)) * 256 + (row & 255)) * 64 + 8 * c) = o; }
    asm volatile("s_waitcnt lgkmcnt(0)" ::: "memory");
}
__device__ __forceinline__ void rows4_to_bf16_norm(const float* xrow, bf16* orow, int lane) {
    f32x4 v[4][4];
#pragma unroll
    for (int r = 0; r < 4; ++r)
#pragma unroll
        for (int j = 0; j < 4; ++j) v[r][j] = __builtin_nontemporal_load((const f32x4*)(xrow + (size_t)r * DM) + 64 * j + lane);
#pragma unroll
    for (int r = 0; r < 4; ++r) { float s = 0.f;
#pragma unroll
        for (int j = 0; j < 4; ++j) s += (v[r][j].x * v[r][j].x + v[r][j].y * v[r][j].y) + (v[r][j].z * v[r][j].z + v[r][j].w * v[r][j].w);
        const float rs = __builtin_amdgcn_rsqf(wave_sum(s) * (1.0f / 1024.0f) + 1e-6f);
        u32x2* o8 = (u32x2*)(orow + (size_t)r * DM) + lane;
#pragma unroll
        for (int j = 0; j < 4; ++j) { u32x2 w; w.x = pk2(v[r][j].x * rs, v[r][j].y * rs); w.y = pk2(v[r][j].z * rs, v[r][j].w * rs); o8[64 * j] = w; } }
}
namespace att {
constexpr int ROWB = 144, KOFF = 0, VOFF = 256 * ROWB;
constexpr float LOG2E = 1.4426950408889634f;
__device__ __forceinline__ int crow(int r, int h) { return (r & 3) + 8 * (r >> 2) + 4 * h; }
__device__ __forceinline__ void sincos_rev(float ang, float& s, float& c) {
    const float hi = ang * 0.15915493667125702f, lo = __builtin_fmaf(ang, 0.15915493667125702f, -hi) + ang * 6.4206382432985265e-09f;
    const float r = __builtin_amdgcn_fractf(hi) + lo; s = __builtin_amdgcn_sinf(r); c = __builtin_amdgcn_cosf(r);
}
__device__ __forceinline__ float inv_freq(int i) {
    return i == 0 ? 1.0f : i == 1 ? 0.19392274474868576f : i == 2 ? 0.03760603093086393f : i == 3 ? 0.007292664737217109f : i == 4 ? 0.001414213562373095f : i == 5 ? 0.0002742481756762073f : i == 6 ? 5.318295896944988e-05f : 1.031338537721246e-05f;
}
__device__ __forceinline__ void kv_issue(u32x4 (&kr)[4], u32x4 (&vr)[4], const bf16* Ksrc, const bf16* Vsrc, int ld, int row_lo, int tid) {
    const int key = tid >> 1, half = tid & 1;
#pragma unroll
    for (int c = 0; c < 4; ++c) { kr[c] = (u32x4){0u, 0u, 0u, 0u}; vr[c] = (u32x4){0u, 0u, 0u, 0u}; }
    if (key >= row_lo) {
        const u32x4* kp = (const u32x4*)(Ksrc + (long)key * ld + 32 * half); const u32x4* vp = (const u32x4*)(Vsrc + (long)key * ld + 32 * half);
#pragma unroll
        for (int c = 0; c < 4; ++c) { kr[c] = kp[c]; vr[c] = vp[c]; }
    }
}
template <bool ROPE> __device__ __forceinline__ void kv_finish(LAS unsigned char* lds, const u32x4 (&kr)[4], const u32x4 (&vr)[4], const float* gk, const float* gq, float p, int tid) {
    const int key = tid >> 1, half = tid & 1;
    f32x4 gkv[8], gqv[8];
#pragma unroll
    for (int c = 0; c < 8; ++c) { gkv[c] = *(const f32x4*)(gk + 32 * half + 4 * c); gqv[c] = *(const f32x4*)(gq + 32 * half + 4 * c); }
    LAS unsigned char* vdst = lds + VOFF + key * ROWB + 64 * half;
#pragma unroll
    for (int c = 0; c < 4; ++c) *(LAS u32x4*)(vdst + 16 * c) = vr[c];
    float f[32]; float ss = 0.f;
#pragma unroll
    for (int c = 0; c < 4; ++c)
#pragma unroll
        for (int w = 0; w < 4; ++w) { const unsigned x = kr[c][w]; f[8 * c + 2 * w] = bflo(x); f[8 * c + 2 * w + 1] = bfhi(x); }
#pragma unroll
    for (int i = 0; i < 32; ++i) ss += f[i] * f[i];
    ss += __shfl_xor(ss, 1);
    const float rs = __builtin_amdgcn_rsqf(ss * (1.0f / 64.0f) + 1e-6f);
#pragma unroll
    for (int i = 0; i < 32; ++i) { const float gkk = gkv[i >> 2][i & 3], gqq = gqv[i >> 2][i & 3]; f[i] *= rs * ((ROPE && i < 16) ? (half == 0 ? gkk : gkk * gqq) : gkk * gqq); }
    if (ROPE) {
        if (half == 0) {
#pragma unroll
            for (int i = 0; i < 8; ++i) { float s, c; sincos_rev(p * inv_freq(i), s, c); const float x1 = f[i], x2 = f[8 + i]; f[i] = x1 * c - x2 * s; f[8 + i] = x2 * c + x1 * s; }
        }
    }
    LAS unsigned char* kdst = lds + KOFF + key * ROWB + 64 * half;
#pragma unroll
    for (int c = 0; c < 4; ++c) { u32x4 w; w.x = pk2(f[8 * c], f[8 * c + 1]); w.y = pk2(f[8 * c + 2], f[8 * c + 3]); w.z = pk2(f[8 * c + 4], f[8 * c + 5]); w.w = pk2(f[8 * c + 6], f[8 * c + 7]); *(LAS u32x4*)(kdst + 16 * c) = w; }
}
__device__ __forceinline__ void q_issue(u32x4 (&raw)[4], const bf16* Qrow0, int ldq, int lane) {
    const int ql = lane & 31, h = lane >> 5;
#pragma unroll
    for (int ds = 0; ds < 4; ++ds) raw[ds] = *(const u32x4*)(Qrow0 + (long)ql * ldq + 16 * ds + 8 * h);
}
template <int NKT, bool SWA> __device__ __forceinline__ void attn_wave(LAS unsigned char* lds, const u32x4 (&raw)[4], const f32x4 (&g0)[2], float p_, float sink2, int t0, bool blk0, bf16* Orow0, int ldo, int lane) {
    const int ql = lane & 31, h = lane >> 5;
    float f[4][8]; float ss = 0.f;
#pragma unroll
    for (int ds = 0; ds < 4; ++ds)
#pragma unroll
        for (int w = 0; w < 4; ++w) { const unsigned x = raw[ds][w]; f[ds][2 * w] = bflo(x); f[ds][2 * w + 1] = bfhi(x); }
#pragma unroll
    for (int ds = 0; ds < 4; ++ds)
#pragma unroll
        for (int i = 0; i < 8; ++i) ss += f[ds][i] * f[ds][i];
    ss += __shfl_xor(ss, 32);
    const float rs = __builtin_amdgcn_rsqf(ss * (1.0f / 64.0f) + 1e-6f) * (0.125f * LOG2E);
#pragma unroll
    for (int ds = 0; ds < 4; ++ds)
#pragma unroll
        for (int i = 0; i < 8; ++i) f[ds][i] *= rs;
    if (SWA) {
#pragma unroll
        for (int i = 0; i < 8; ++i) f[0][i] *= g0[i >> 2][i & 3];
#pragma unroll
        for (int i = 0; i < 8; ++i) { float s, c; sincos_rev(p_ * inv_freq(i), s, c); const float other = __shfl_xor(f[0][i], 32); f[0][i] = f[0][i] * c + (h ? other : -other) * s; }
    }
    bf16x8 qf[4];
#pragma unroll
    for (int ds = 0; ds < 4; ++ds) { u32x4 w; w.x = pk2(f[ds][0], f[ds][1]); w.y = pk2(f[ds][2], f[ds][3]); w.z = pk2(f[ds][4], f[ds][5]); w.w = pk2(f[ds][6], f[ds][7]); qf[ds] = __builtin_bit_cast(bf16x8, w); }
    constexpr float SOFF = 8.0f;
    f32x16 p[NKT];
#pragma unroll
    for (int kt = 0; kt < NKT; ++kt) {
#pragma unroll
        for (int r = 0; r < 16; ++r) p[kt][r] = -SOFF;
        const LAS unsigned char* kb = lds + KOFF + (32 * (t0 + kt) + ql) * ROWB + 16 * h;
#pragma unroll
        for (int ds = 0; ds < 4; ++ds) { const bf16x8 a = *(const LAS bf16x8*)(kb + 32 * ds); p[kt] = __builtin_amdgcn_mfma_f32_32x32x16_bf16(a, qf[ds], p[kt], 0, 0, 0); }
    }
    const float NEG = -INFINITY;
    if (SWA) {
#pragma unroll
        for (int r = 0; r < 16; ++r) { const int kvl = crow(r, h); if (kvl <= ql) p[0][r] = NEG; if (kvl > ql) p[NKT - 1][r] = NEG; }
        if (blk0) {
#pragma unroll
            for (int kt = 0; kt < NKT; ++kt) if (t0 + kt < 4) {
#pragma unroll
                for (int r = 0; r < 16; ++r) p[kt][r] = NEG; }
        }
    }
    float l = 0.f;
#pragma unroll
    for (int kt = 0; kt < NKT; ++kt)
#pragma unroll
        for (int r = 0; r < 16; ++r) { p[kt][r] = __builtin_amdgcn_exp2f(p[kt][r]); l += p[kt][r]; }
    l += __shfl_xor(l, 32);
    if (SWA) l += __builtin_amdgcn_exp2f(sink2 - SOFF);
    const float inv = 1.0f / l;
    f32x16 o[2];
#pragma unroll
    for (int db = 0; db < 2; ++db)
#pragma unroll
        for (int r = 0; r < 16; ++r) o[db][r] = 0.f;
    const LAS unsigned char* vb = lds + VOFF + (4 * h + ((lane & 15) >> 2)) * ROWB + (16 * ((lane >> 4) & 1) + 4 * (lane & 3)) * 2;
#pragma unroll
    for (int kt = 0; kt < NKT; ++kt)
#pragma unroll
        for (int s = 0; s < 2; ++s) {
            u32x4 w; w.x = pk2(p[kt][8 * s], p[kt][8 * s + 1]); w.y = pk2(p[kt][8 * s + 2], p[kt][8 * s + 3]); w.z = pk2(p[kt][8 * s + 4], p[kt][8 * s + 5]); w.w = pk2(p[kt][8 * s + 6], p[kt][8 * s + 7]);
            const bf16x8 pf = __builtin_bit_cast(bf16x8, w);
            const LAS unsigned char* vp = vb + (32 * (t0 + kt) + 16 * s) * ROWB;
#pragma unroll
            for (int db = 0; db < 2; ++db) {
                const s16x4 lo = __builtin_bit_cast(s16x4, __builtin_amdgcn_ds_read_tr16_b64_v4i16((LAS s16x4*)(vp + 64 * db)));
                const s16x4 hi = __builtin_bit_cast(s16x4, __builtin_amdgcn_ds_read_tr16_b64_v4i16((LAS s16x4*)(vp + 64 * db + 8 * ROWB)));
                const bf16x8 a = (bf16x8){lo[0], lo[1], lo[2], lo[3], hi[0], hi[1], hi[2], hi[3]};
                o[db] = __builtin_amdgcn_mfma_f32_32x32x16_bf16(a, pf, o[db], 0, 0, 0);
            }
        }
    bf16* orow = Orow0 + (long)ql * ldo;
#pragma unroll
    for (int db = 0; db < 2; ++db)
#pragma unroll
        for (int g = 0; g < 4; ++g) { u32x2 w; w.x = pk2(o[db][4 * g] * inv, o[db][4 * g + 1] * inv); w.y = pk2(o[db][4 * g + 2] * inv, o[db][4 * g + 3] * inv);
            *(u32x2*)(orow + 32 * db + 8 * g + 4 * h) = w; }
}
}

__device__ __forceinline__ void conv_unit(LAS unsigned char* lds, const bf16* proj, int b, int tt, const float* w_dw, const float* b_dw, const float* g_ln, const float* b_ln, bf16* y, int tid) {
    LAS float* H = (LAS float*)lds;
    const int t0 = tt * 64;
    {
        u32x4 av[6];
#pragma unroll
        for (int k = 0; k < 6; ++k) {
            const int idx = tid + k * NTHR, tk = idx >> 5, ch = idx & 31, t = t0 - 30 + tk;
            av[k] = (u32x4){0u, 0u, 0u, 0u};
            if (idx < 94 * 32 && t >= 0) av[k] = *(const u32x4*)(proj + (size_t)(b * SEQ + t) * INC + 1024 + ch * 8);
        }
#pragma unroll
        for (int k = 0; k < 6; ++k) {
            const int idx = tid + k * NTHR, tk = idx >> 5, ch = idx & 31;
            if (idx < 94 * 32) { *(LAS f32x4*)(H + tk * 256 + ch * 8) = (f32x4){bflo(av[k][0]), bfhi(av[k][0]), bflo(av[k][1]), bfhi(av[k][1])};
                                 *(LAS f32x4*)(H + tk * 256 + ch * 8 + 4) = (f32x4){bflo(av[k][2]), bfhi(av[k][2]), bflo(av[k][3]), bfhi(av[k][3])}; }
        }
    }
    __syncthreads();
    {
        const int cp = tid & 127, tg = tid >> 7;
        f32x2_t w2[31];
#pragma unroll
        for (int j = 0; j < 31; ++j) w2[j] = *(const f32x2_t*)(w_dw + j * 256 + 2 * cp);
        const f32x2_t bias2 = *(const f32x2_t*)(b_dw + 2 * cp);
        f32x2_t outv[16];
#pragma unroll
        for (int ck = 0; ck < 2; ++ck) {
            f32x2_t hv[38];
#pragma unroll
            for (int i = 0; i < 38; ++i) hv[i] = *(const LAS f32x2_t*)(H + (tg * 16 + ck * 8 + i) * 256 + 2 * cp);
#pragma unroll
            for (int k = 0; k < 8; ++k) { f32x2_t acc2 = bias2;
#pragma unroll
                for (int j = 0; j < 31; ++j) acc2 = __builtin_elementwise_fma(w2[j], hv[k + j], acc2);
                outv[ck * 8 + k] = acc2; }
        }
        __syncthreads();
#pragma unroll
        for (int k = 0; k < 16; ++k) *(LAS f32x2_t*)(H + (tg * 16 + k) * 256 + 2 * cp) = outv[k];
        __syncthreads();
    }
    const int wv = tid >> 6, lane = tid & 63;
    const f32x4 gg = *(const f32x4*)(g_ln + 4 * lane), bb = *(const f32x4*)(b_ln + 4 * lane);
#pragma unroll
    for (int k = 0; k < 8; ++k) {
        const int tok = wv * 8 + k; f32x4 v = *(LAS f32x4*)(H + tok * 256 + 4 * lane);
        const float mean = wave_sum((v.x + v.y) + (v.z + v.w)) * (1.0f / 256.0f);
        v = v - mean;
        const float var = wave_sum((v.x * v.x + v.y * v.y) + (v.z * v.z + v.w * v.w)) * (1.0f / 256.0f);
        const float rs = __builtin_amdgcn_rsqf(var + 1e-6f);
        v = v * rs * gg + bb;
        float o[4];
#pragma unroll
        for (int i = 0; i < 4; ++i) o[i] = v[i] * __builtin_amdgcn_rcpf(1.0f + __builtin_amdgcn_exp2f(-1.4426950408889634f * v[i]));
        u32x2 pw; pw.x = pk2(o[0], o[1]); pw.y = pk2(o[2], o[3]);
        *(u32x2*)(y + (size_t)(b * SEQ + t0 + tok) * DM + 512 + 4 * lane) = pw;
    }
    __syncthreads();
}

#define XB_TMO      128
#define XB_XCNT(j)  (256  + 64 * (j))
#define XB_XSUB(j)  (1280 + 64 * (j))
#define XB_XGEN(j)  (2304 + 64 * (j))
#define XB_TOP      3328
#define XB_TOPGEN   3392
#define XCD_BAR_WORDS 3456
#define XB_SPIN_CAP (1u << 18)

__device__ __forceinline__ unsigned xb_ld(unsigned* p)              { return __hip_atomic_load(p, __ATOMIC_RELAXED, __HIP_MEMORY_SCOPE_AGENT); }
__device__ __forceinline__ unsigned xb_add(unsigned* p, unsigned v) { return __hip_atomic_fetch_add(p, v, __ATOMIC_RELAXED, __HIP_MEMORY_SCOPE_AGENT); }
__device__ __forceinline__ unsigned xb_xcc_id() { return (unsigned)__builtin_amdgcn_s_getreg((3 << 11) | 20) & 0xFu; }
#define XB_SPIN(cond, bar) do { unsigned _sp = 0; while (cond) { __builtin_amdgcn_s_sleep(1); \
    if ((++_sp & 255u) == 0u) { if (xb_ld(&(bar)[XB_TMO])) break; if (_sp > XB_SPIN_CAP) { atomicAdd(&(bar)[XB_TMO], 1u); break; } } } } while (0)

struct XcdBarrier {
    unsigned* bar; unsigned x;
    volatile LAS unsigned* st;
};

__device__ __forceinline__ XcdBarrier xcd_barrier_post(unsigned* bar, volatile LAS unsigned* st) {
    XcdBarrier b; b.bar = bar; b.x = xb_xcc_id(); b.st = st;
    if (threadIdx.x == 0) (void)xb_add(&bar[XB_XCNT(b.x)], 1u);
    return b;
}
__device__ __forceinline__ void xcd_barrier_complete(unsigned* bar, unsigned x, unsigned& nloc, unsigned& nx) {
    const unsigned G = gridDim.x * gridDim.y * gridDim.z;
    unsigned sum, cnt, mine, sp = 0u;
    for (;;) {
        sum = 0u; cnt = 0u; mine = 0u;
#pragma unroll
        for (unsigned j = 0; j < 16; ++j) { const unsigned c = xb_ld(&bar[XB_XCNT(j)]); sum += c; cnt += (c > 0u) ? 1u : 0u; mine = (j == x) ? c : mine; }
        if (sum == G) break;
        __builtin_amdgcn_s_sleep(1);
        if ((++sp & 255u) == 0u) { if (xb_ld(&bar[XB_TMO])) break; if (sp > XB_SPIN_CAP) { atomicAdd(&bar[XB_TMO], 1u); break; } }
    }
    nloc = mine > 0u ? mine : 1u; nx = cnt > 0u ? cnt : 1u;
}

__device__ __forceinline__ void xcd_barrier(const XcdBarrier& b) {
    asm volatile("s_waitcnt vmcnt(0)" ::: "memory");
    __syncthreads();
    if (threadIdx.x == 0) {
        unsigned* bar = b.bar;
        __builtin_amdgcn_s_waitcnt(0);
        unsigned nloc = b.st[0], nx = b.st[1];
        if (nloc == 0u) { xcd_barrier_complete(bar, b.x, nloc, nx); b.st[0] = nloc; b.st[1] = nx; }
        const unsigned old = xb_add(&bar[XB_XSUB(b.x)], 1u);
        const unsigned gen = old / nloc;
        if (old + 1u == (gen + 1u) * nloc) {
            __builtin_amdgcn_fence(__ATOMIC_RELEASE, "agent");
            asm volatile("s_waitcnt vmcnt(0)" ::: "memory");
            const unsigned og = xb_add(&bar[XB_TOP], 1u);
            const unsigned tg = og / nx;
            if (og + 1u == (tg + 1u) * nx) xb_add(&bar[XB_TOPGEN], 1u);
            else XB_SPIN(xb_ld(&bar[XB_TOPGEN]) == tg, bar);
            __builtin_amdgcn_fence(__ATOMIC_ACQUIRE, "agent");
            xb_add(&bar[XB_XGEN(b.x)], 1u);
            asm volatile("s_waitcnt vmcnt(0)" ::: "memory");
        } else {
            asm volatile("buffer_inv sc1" ::: "memory");
            XB_SPIN(xb_ld(&bar[XB_XGEN(b.x)]) == gen, bar);
            asm volatile("s_waitcnt vmcnt(0)" ::: "memory");
        }
    }
    __syncthreads();
}

struct Args { const float* in[25]; float* out; unsigned char* ws; int ph_lo, ph_hi, li, pad; };
constexpr int NPHASE = 9;
__global__ void __launch_bounds__(NTHR, 2) fwd_kernel(Args a) {
    extern __shared__ __attribute__((aligned(16))) unsigned char lds_raw[];
    LAS unsigned char* lds = (LAS unsigned char*)lds_raw;
    cg::grid_group grid = cg::this_grid();
    const int tid = threadIdx.x, lane = tid & 63, wave = __builtin_amdgcn_readfirstlane(tid >> 6);
    const int G = gridDim.x, bx = blockIdx.x;
    unsigned char* ws = a.ws;
    const float* x = a.in[0]; const float* mem = a.in[1]; const int* positions = (const int*)a.in[2];
    float* ss0 = (float*)(ws + WS_SS0); float* ss1 = (float*)(ws + WS_SS1); float* ss2 = (float*)(ws + WS_SS2); float* ssm = (float*)(ws + WS_SSM);
    bf16* W1GU = (bf16*)(ws + WS_W1GU); bf16* W1D = (bf16*)(ws + WS_W1D); bf16* W2GU = (bf16*)(ws + WS_W2GU); bf16* W2D = (bf16*)(ws + WS_W2D);
    bf16* WIN = (bf16*)(ws + WS_WIN); bf16* WOUT = (bf16*)(ws + WS_WOUT); bf16* WMKV = (bf16*)(ws + WS_WMKV);
    bf16* XB = (bf16*)(ws + WS_XB); bf16* ACT = (bf16*)(ws + WS_ACT); bf16* PROJ = (bf16*)(ws + WS_PROJ); bf16* Y = (bf16*)(ws + WS_Y);
    bf16* MEMB = (bf16*)(ws + WS_MEMB); bf16* MKV = (bf16*)(ws + WS_MKV);
    const int lo = a.ph_lo, hi = a.ph_hi;
#define IN(k) (lo <= (k) && (k) < hi)
    volatile LAS unsigned* MISC = (volatile LAS unsigned*)(lds + LDS_BYTES - 128);
    if (tid < 32) MISC[tid] = 0u;
    __syncthreads();
    const XcdBarrier bar = xcd_barrier_post((unsigned*)(ws + WS_CTL) + a.li * XCD_BAR_WORDS, MISC + 8);
    if (a.ph_lo < 0) grid.sync();
#define SEAM(k) do { if (IN(k) && IN((k) + 1)) xcd_barrier(bar); } while (0)

    if (IN(0)) {
        LAS float* scr = (LAS float*)(lds + wave * 16640);
        const int gw = bx * NWAVES + wave, NGW = G * NWAVES;
        constexpr int I_GU = (DM / 64) * (DFF / 64), I_D = (DFF / 64) * (DM / 64), I_IN = (DM / 64) * (INC / 64), I_OUT = (DM / 64) * (DM / 64), I_MKV = (DM / 64) * (512 / 64);
        constexpr int NITEMS = 2 * I_GU + I_MKV, NXG = M / 4, NMG = MROWS / 4;
        for (int it = gw; it < NITEMS + NXG + NMG; it += NGW) {
            int r = it;
            if (r < I_GU) { transpose_item(a.in[4], DM, DFF, W1GU, 1, a.in[3], 1.f, scr, r, lane); continue; } r -= I_GU;
            if (r < I_GU) { transpose_item(a.in[5], DM, DFF, W1GU, 2, a.in[3], 1.f, scr, r, lane); continue; } r -= I_GU;
            if (r < I_MKV) { transpose_item(a.in[17], DM, 512, WMKV, 0, a.in[16], 1.f, scr, r, lane); continue; } r -= I_MKV;
            if (r < NXG) { rows4_to_bf16_norm(x + (size_t)r * 4 * DM, XB + (size_t)r * 4 * DM, lane); continue; } r -= NXG;
            rows4_to_bf16_norm(mem + (size_t)r * 4 * DM, MEMB + (size_t)r * 4 * DM, lane);
        }
        for (int i = bx * NTHR + tid; i < M; i += G * NTHR) ss2[i] = 0.f;
        __syncthreads();
    }
    SEAM(0);
    if (IN(1)) {
        for (int i = bx * NTHR + tid; i < M; i += G * NTHR) ss1[i] = 0.f;
        { pg8::Gemm g{XB, W1GU, M, 2 * DFF, DM, 2 * DM, 128, 128, 32768}; pg8::StaticOrder S; S.init(M, 2 * DFF, G, bx); pg8::EpiSwiGLU<false> E{ACT, DFF, nullptr};
          pg8::gemm_phase<pg8::EpiSwiGLU<false>, pg8::StaticOrder, true, true>(lds, g, S, E); }
        { pg8::Gemm g{MEMB, WMKV, MROWS, 512, DM, 2 * DM, 128, 128, 32768}; pg8::ExtraOrder S{bx, G >= 160 ? 128 : 0, 2, 16}; pg8::EpiScaleBf16<false> E{MKV, 512, nullptr};
          pg8::gemm_phase<pg8::EpiScaleBf16<false>, pg8::ExtraOrder, true, true>(lds, g, S, E); }
        {
            const int c0 = G >= 160 ? 144 : 0;
            if (bx >= c0) {
                LAS float* scr = (LAS float*)(lds + wave * 16640);
                constexpr int I_GU = (DM / 64) * (DFF / 64), I_D = (DFF / 64) * (DM / 64), I_IN = (DM / 64) * (INC / 64), I_OUT = (DM / 64) * (DM / 64);
                for (int it = (bx - c0) * NWAVES + wave; it < 2 * I_GU + 2 * I_D + I_IN + I_OUT; it += (G - c0) * NWAVES) {
                    int r = it;
                    if (r < I_D) { transpose_item(a.in[6], DFF, DM, W1D, 0, nullptr, 0.5f, scr, r, lane); continue; } r -= I_D;
                    if (r < I_IN) { transpose_item(a.in[8], DM, INC, WIN, 3, a.in[7], 1.f, scr, r, lane); continue; } r -= I_IN;
                    if (r < I_OUT) { transpose_item(a.in[20], DM, DM, WOUT, 0, nullptr, 1.f, scr, r, lane); continue; } r -= I_OUT;
                    if (r < I_GU) { transpose_item(a.in[22], DM, DFF, W2GU, 1, a.in[21], 1.f, scr, r, lane); continue; } r -= I_GU;
                    if (r < I_GU) { transpose_item(a.in[23], DM, DFF, W2GU, 2, a.in[21], 1.f, scr, r, lane); continue; } r -= I_GU;
                    transpose_item(a.in[24], DFF, DM, W2D, 0, nullptr, 0.5f, scr, r, lane);
                }
            }
        }
    }
    SEAM(1);
    if (IN(2)) {
        pg8::Gemm g{ACT, W1D, M, DM, DFF, 128, 32768, 128, 32768}; pg8::StaticOrder S; S.init(M, DM, G, bx); pg8::EpiResid<0> E{x, nullptr, XB, ss1};
        pg8::gemm_phase<pg8::EpiResid<0>, pg8::StaticOrder, true, true>(lds, g, S, E);
    }
    SEAM(2);
    if (IN(3)) {
        pg8::Gemm g{XB, WIN, M, 1024, DM, 2 * DM, 128, 128, 32768}; pg8::StaticOrder S; S.init(M, 1024, G, bx); pg8::EpiScaleBf16<true> E{PROJ, INC, ss1};
        pg8::gemm_phase<pg8::EpiScaleBf16<true>, pg8::StaticOrder, true, true>(lds, g, S, E);
    }
    SEAM(3);
#define SWA_UNIT(u_) do { const int u = (u_); const int b = u >> 5, g = (u >> 4) & 1, n = u & 15; \
            const long krow0 = (long)b * SEQ + (n - 1) * 128; const int hq = g * 4 + (wave >> 1); const long qrow = (long)b * SEQ + n * 128 + 64 * (wave & 1); \
            u32x4 kr[4], vr[4], raw0[4], raw1[4]; \
            att::kv_issue(kr, vr, PROJ + krow0 * INC + 512 + g * 64, PROJ + krow0 * INC + 640 + g * 64, INC, n == 0 ? 128 : 0, tid); \
            att::q_issue(raw0, PROJ + qrow * INC + hq * 64, INC, lane); att::q_issue(raw1, PROJ + (qrow + 32) * INC + hq * 64, INC, lane); \
            const int kpos = ((tid >> 1) >= (n == 0 ? 128 : 0)) ? positions[krow0 + (tid >> 1)] : 0; const int qp0 = positions[qrow + (lane & 31)], qp1 = positions[qrow + 32 + (lane & 31)]; \
            f32x4 g0[2]; g0[0] = *(const f32x4*)(a.in[9] + 8 * (lane >> 5)); g0[1] = *(const f32x4*)(a.in[9] + 8 * (lane >> 5) + 4); \
            const float sink2 = a.in[11][hq] * att::LOG2E; \
            att::kv_finish<true>(lds, kr, vr, a.in[10], a.in[9], (float)kpos, tid); \
            __syncthreads(); \
            att::attn_wave<5, true>(lds, raw0, g0, (float)qp0, sink2, 2 * (wave & 1), n == 0, Y + qrow * DM + hq * 64, DM, lane); \
            att::attn_wave<5, true>(lds, raw1, g0, (float)qp1, sink2, 2 * (wave & 1) + 1, n == 0, Y + (qrow + 32) * DM + hq * 64, DM, lane); \
            __syncthreads(); } while (0)
#define MEM_UNIT(u_) do { const int u = (u_); const int b = u >> 5, hm = (u >> 3) & 3, qt = u & 7; \
            const long qrow = (long)b * SEQ + qt * 256 + 32 * wave; \
            u32x4 kr[4], vr[4], raw0[4]; \
            att::kv_issue(kr, vr, MKV + (long)b * MEML * 512 + hm * 64, MKV + (long)b * MEML * 512 + 256 + hm * 64, 512, 0, tid); \
            att::q_issue(raw0, PROJ + qrow * INC + 768 + hm * 64, INC, lane); \
            f32x4 g0[2]; g0[0] = (f32x4){1.f, 1.f, 1.f, 1.f}; g0[1] = g0[0]; \
            att::kv_finish<false>(lds, kr, vr, a.in[19], a.in[18], 0.f, tid); \
            __syncthreads(); \
            att::attn_wave<8, false>(lds, raw0, g0, 0.f, 0.f, 0, false, Y + qrow * DM + 768 + hm * 64, DM, lane); \
            __syncthreads(); } while (0)
    if (IN(4)) {
        { pg8::Gemm g{XB, WIN + (size_t)1024 * DM, M, 512, DM, 2 * DM, 128, 128, 32768}; pg8::StaticOrder S; S.init(M, 512, G, bx); pg8::EpiGLU E{PROJ + 1024, INC, ss1};
          pg8::gemm_phase<pg8::EpiGLU, pg8::StaticOrder, true, true>(lds, g, S, E); }
        if (G == 256) {
            if (bx < 128) { MEM_UNIT(128 + bx); }
            else { SWA_UNIT(bx - 128); SWA_UNIT(bx); MEM_UNIT(bx - 128); }
        } else {
#pragma unroll 1
            for (int u = bx; u < 256; u += G) SWA_UNIT(u);
#pragma unroll 1
            for (int u = bx; u < 256; u += G) MEM_UNIT(u);
        }
    }
    SEAM(4);
    if (IN(5)) {
#pragma unroll 1
        for (int u = bx; u < 256; u += G) conv_unit(lds, PROJ, u >> 5, u & 31, a.in[12], a.in[13], a.in[14], a.in[15], Y, tid);
    }
    SEAM(5);
    if (IN(6)) {
        pg8::Gemm g{Y, WOUT, M, DM, DM, 2 * DM, 128, 128, 32768}; pg8::StaticOrder S; S.init(M, DM, G, bx); pg8::EpiResid<1> E{nullptr, nullptr, XB, ss2};
        pg8::gemm_phase<pg8::EpiResid<1>, pg8::StaticOrder, true, true>(lds, g, S, E);
    }
    SEAM(6);
    if (IN(7)) {
        pg8::Gemm g{XB, W2GU, M, 2 * DFF, DM, 2 * DM, 128, 128, 32768}; pg8::StaticOrder S; S.init(M, 2 * DFF, G, bx); pg8::EpiSwiGLU<true> E{ACT, DFF, ss2};
        pg8::gemm_phase<pg8::EpiSwiGLU<true>, pg8::StaticOrder, true, true>(lds, g, S, E);
    }
    SEAM(7);
    if (IN(8)) {
        pg8::Gemm g{ACT, W2D, M, DM, DFF, 128, 32768, 128, 32768}; pg8::StaticOrder S; S.init(M, DM, G, bx); pg8::EpiResid<2> E{nullptr, a.out, XB, nullptr};
        pg8::gemm_phase<pg8::EpiResid<2>, pg8::StaticOrder, true, true>(lds, g, S, E);
    }
#undef IN
#undef SEAM
}

extern "C" void kernel_launch(void* const* d_in, const int* in_sizes, int n_in, void* d_out, int out_size, void* d_ws, size_t ws_size, hipStream_t stream) {
    static int grid = 0;
    if (grid == 0) {
        int dev = 0, cus = 0, per_cu = 0;
        if (n_in != 25 || out_size != M * DM || ws_size < WS_END) { fprintf(stderr, "kernel_launch: unexpected shapes (n_in %d out %d ws %zu)\n", n_in, out_size, ws_size); grid = -1; return; }
        (void)hipGetDevice(&dev); (void)hipDeviceGetAttribute(&cus, hipDeviceAttributeMultiprocessorCount, dev);
        (void)hipFuncSetAttribute((const void*)fwd_kernel, hipFuncAttributeMaxDynamicSharedMemorySize, LDS_BYTES);
        (void)hipOccupancyMaxActiveBlocksPerMultiprocessor(&per_cu, (const void*)fwd_kernel, NTHR, LDS_BYTES);
        if (per_cu < 1) { fprintf(stderr, "kernel_launch: occupancy query says %d blocks per CU\n", per_cu); per_cu = 1; }
        (void)hipGetLastError();
        grid = cus;
    }
    if (grid < 0) return;
    if (hipMemsetAsync((char*)d_ws + WS_CTL, 0, CTL_BYTES, stream) != hipSuccess) { fprintf(stderr, "kernel_launch: memset failed\n"); return; }
    Args a{};
    for (int i = 0; i < 25; ++i) a.in[i] = (const float*)d_in[i];
    a.out = (float*)d_out; a.ws = (unsigned char*)d_ws;
    a.ph_lo = 0; a.ph_hi = NPHASE; a.li = 0;
    {
        void* args[] = {&a};
        hipError_t e = hipLaunchCooperativeKernel((const void*)fwd_kernel, dim3(grid), dim3(NTHR), args, LDS_BYTES, stream);
        if (e != hipSuccess) { fprintf(stderr, "kernel_launch: cooperative launch failed: %s (grid %d)\n", hipGetErrorString(e), grid); }
    }
}
```
